# Optimizing an MI355X kernel written in HIP

```python
import jax, jax.numpy as jnp
from jax import lax
import numpy as np

D_MODEL = 1024
BATCH = 8
SEQ = 4096
DEPTH = 4

GRID_W = 64
CTX_LEN = 256
D_FF = 2816
N_SUB = 3
N_MOD = 3 * N_SUB
FFN_HALF = 0.5
NORM_EPS = 1e-6
ROPE_THETA = 10000.0
DEEP_ALPHA = (2 * DEPTH) ** 0.25
DEEP_BETA = (8 * DEPTH) ** -0.25

A_HEADS = 8
A_KV = 2
A_HD = 64
WINDOW = 128
BLOCK = 128
B_HEADS = 4
B_DK = 128
B_DV = 128
CONV_K = 5
CHUNK = 64
C_HEADS = 8
C_KV = 2
C_HD = 128
Q_BLOCK = 128

N_EVEN = (DEPTH + 1) // 2
N_ODD = DEPTH // 2
A_Q = A_HEADS * A_HD
A_KVW = A_KV * A_HD
B_QK = B_HEADS * B_DK
B_VW = B_HEADS * B_DV
B_QKV = 2 * B_QK + B_VW
AB_SIZES = (A_Q, A_KVW, A_KVW, B_QKV, B_VW, B_HEADS, B_HEADS, B_HEADS, B_HEADS)
AB_IN = A_Q + 2 * A_KVW + B_QKV + B_VW + 4 * B_HEADS
AB_OUT = A_Q + B_VW
C_IN = C_HEADS * C_HD + 2 * C_KV * C_HD
C_OUT = C_HEADS * C_HD

kernel_name = 'hybrid_dit_window_delta_axial_gqa'


def _split(p, sizes):
    out, start = [], 0
    for s in sizes:
        out.append(p[..., start:start + s])
        start += s
    return out


def layer_norm(x, g, b):
    x32 = x.astype(jnp.float32)
    mu = jnp.mean(x32, axis=-1, keepdims=True)
    var = jnp.mean(jnp.square(x32 - mu), axis=-1, keepdims=True)
    return ((x32 - mu) * lax.rsqrt(var + NORM_EPS) * g + b).astype(x.dtype)


def rms_norm(x, g):
    x32 = x.astype(jnp.float32)
    return (x32 * lax.rsqrt(jnp.mean(jnp.square(x32), axis=-1, keepdims=True) + NORM_EPS) * g).astype(x.dtype)


def l2_normalize(x):
    x32 = x.astype(jnp.float32)
    return (x32 * lax.rsqrt(jnp.sum(jnp.square(x32), axis=-1, keepdims=True) + NORM_EPS)).astype(x.dtype)


def axial_rope(rows, head_dim):
    n_freq = head_dim // 4
    inv = ROPE_THETA ** (-jnp.arange(n_freq, dtype=jnp.float32) / n_freq)
    r, col = jnp.meshgrid(jnp.arange(rows, dtype=jnp.float32), jnp.arange(GRID_W, dtype=jnp.float32), indexing='ij')
    r, col = r.reshape(-1), col.reshape(-1)
    ang = jnp.concatenate([r[:, None] * inv, col[:, None] * inv], axis=-1)
    return jnp.cos(ang), jnp.sin(ang)


def apply_rope(x, cos, sin):
    half = x.shape[-1] // 2
    x1, x2 = x[..., :half], x[..., half:]
    cs = cos[None, :, None, :].astype(x.dtype)
    sn = sin[None, :, None, :].astype(x.dtype)
    return jnp.concatenate([x1 * cs - x2 * sn, x1 * sn + x2 * cs], axis=-1)


def swiglu(h, w_gu, w_down):
    gate, up = jnp.split(h @ w_gu, 2, axis=-1)
    return (jax.nn.silu(gate) * up) @ w_down


def short_conv(x, w):
    pad = CONV_K // 2
    return lax.conv_general_dilated(x, w[:, None, :].astype(x.dtype), window_strides=(1,), padding=[(pad, pad)],
                                    dimension_numbers=('NWC', 'WIO', 'NWC'), feature_group_count=x.shape[-1])


def ctx_attention(q, k, v, n_kv, sink=None):
    bsz, lq, h, d = q.shape
    g = h // n_kv
    qg = q.reshape(bsz, lq, n_kv, g, d)
    s = jnp.einsum('bqhgd,bkhd->bhgqk', qg, k).astype(jnp.float32) * d ** -0.5
    if sink is not None:
        sk = jnp.broadcast_to(sink.reshape(n_kv, g, 1, 1).astype(jnp.float32), (bsz, n_kv, g, lq, 1))
        s = jnp.concatenate([sk, s], axis=-1)
    p = jax.nn.softmax(s, axis=-1)
    if sink is not None:
        p = p[..., 1:]
    o = jnp.einsum('bhgqk,bkhd->bqhgd', p.astype(v.dtype), v)
    return o.reshape(bsz, lq, h * d)


def window_sink_attention(q, k, v, kc, vc, sink):
    bsz, t = q.shape[:2]
    nb = t // BLOCK
    g = A_HEADS // A_KV
    scale = A_HD ** -0.5
    qb = q.reshape(bsz, nb, BLOCK, A_KV, g, A_HD)

    def band(a):
        ap = jnp.pad(a, ((0, 0), (BLOCK, BLOCK), (0, 0), (0, 0)))
        ab = ap.reshape(bsz, nb + 2, BLOCK, A_KV, A_HD)
        return jnp.concatenate([ab[:, :-2], ab[:, 1:-1], ab[:, 2:]], axis=2)

    kb, vb = band(k), band(v)
    s_loc = jnp.einsum('bnqhgd,bnkhd->bnhgqk', qb, kb).astype(jnp.float32) * scale
    s_ctx = jnp.einsum('bnqhgd,bkhd->bnhgqk', qb, kc).astype(jnp.float32) * scale
    qpos = jnp.arange(nb)[:, None] * BLOCK + jnp.arange(BLOCK)[None, :]
    kpos = (jnp.arange(nb)[:, None] - 1) * BLOCK + jnp.arange(3 * BLOCK)[None, :]
    kp = kpos[:, None, :]
    valid = (jnp.abs(qpos[:, :, None] - kp) <= WINDOW) & (kp >= 0) & (kp < t)
    s_loc = jnp.where(valid[None, :, None, None], s_loc, -jnp.inf)
    sk = jnp.broadcast_to(sink.reshape(A_KV, g, 1, 1).astype(jnp.float32), (bsz, nb, A_KV, g, BLOCK, 1))
    p = jax.nn.softmax(jnp.concatenate([sk, s_loc, s_ctx], axis=-1), axis=-1).astype(v.dtype)
    p_loc, p_ctx = p[..., 1:1 + 3 * BLOCK], p[..., 1 + 3 * BLOCK:]
    o = jnp.einsum('bnhgqk,bnkhd->bnqhgd', p_loc, vb) + jnp.einsum('bnhgqk,bkhd->bnqhgd', p_ctx, vc)
    return o.reshape(bsz, t, A_HEADS * A_HD)


def gated_delta_chunked(q, k, v, beta, g, s0):
    out_dtype = v.dtype
    bsz, t, h, _ = q.shape
    dv = v.shape[-1]
    n = t // CHUNK

    def chunks(a):
        a = a.astype(jnp.float32).reshape((bsz, n, CHUNK) + a.shape[2:])
        return jnp.swapaxes(a, 2, 3)

    qc, kc, vc, bc = chunks(q), chunks(k), chunks(v), chunks(beta)
    gc = jnp.cumsum(chunks(g), axis=-1)
    idx = jnp.arange(CHUNK)
    incl = idx[:, None] >= idx[None, :]
    strict = idx[:, None] > idx[None, :]
    decay = jnp.exp(jnp.where(incl, gc[..., :, None] - gc[..., None, :], -jnp.inf))
    kb = kc * bc[..., None]
    lmat = jnp.where(strict, jnp.einsum('bnhid,bnhjd->bnhij', kb, kc) * decay, 0.0)
    rhs = jnp.concatenate([vc * bc[..., None], kb * jnp.exp(gc)[..., None]], axis=-1)
    uw = lax.linalg.triangular_solve(lmat, rhs, left_side=True, lower=True, unit_diagonal=True)
    u, w = uw[..., :dv], uw[..., dv:]
    attn = jnp.einsum('bnhid,bnhjd->bnhij', qc, kc) * decay
    qd = qc * jnp.exp(gc)[..., None]
    g_last = gc[..., -1]
    kt = kc * jnp.exp(g_last[..., None] - gc)[..., None]

    def step(s, xs):
        u_i, w_i, qd_i, at_i, kt_i, gl_i = xs
        v_new = u_i - jnp.einsum('bhcd,bhde->bhce', w_i, s)
        o_i = jnp.einsum('bhcd,bhde->bhce', qd_i, s) + jnp.einsum('bhij,bhje->bhie', at_i, v_new)
        s = s * jnp.exp(gl_i)[..., None, None] + jnp.einsum('bhcd,bhce->bhde', kt_i, v_new)
        return s, o_i

    xs = tuple(jnp.moveaxis(a, 1, 0) for a in (u, w, qd, attn, kt, g_last))
    s_fin, o = lax.scan(step, s0, xs)
    o = jnp.transpose(o, (1, 0, 3, 2, 4)).reshape(bsz, t, h, dv)
    return o.astype(out_dtype), s_fin


def reverse_delta(q, k, v, beta, g, s0):
    f = lambda a: a[:, ::-1]
    o, s = gated_delta_chunked(f(q), f(k), f(v), f(beta), f(g), s0)
    return f(o), s


def mixer_ab(hl, hc, w_in, conv_w, a_log, dt_bias, gnorm, sink, w_out, cos, sin, ctx_out):
    def prep(h, rope):
        bsz, t, _ = h.shape
        aq, ak, av, bqkv, bz, bbf, bbb, baf, bab = _split(h @ w_in, AB_SIZES)
        aq = aq.reshape(bsz, t, A_HEADS, A_HD)
        ak = ak.reshape(bsz, t, A_KV, A_HD)
        av = av.reshape(bsz, t, A_KV, A_HD)
        if rope:
            aq, ak = apply_rope(aq, cos, sin), apply_rope(ak, cos, sin)
        bq, bk, bv = _split(jax.nn.silu(short_conv(bqkv, conv_w)), (B_QK, B_QK, B_VW))
        bq = l2_normalize(bq.reshape(bsz, t, B_HEADS, B_DK)) * B_DK ** -0.5
        bk = l2_normalize(bk.reshape(bsz, t, B_HEADS, B_DK))
        bv = bv.reshape(bsz, t, B_HEADS, B_DV)
        beta = (jax.nn.sigmoid(bbf), jax.nn.sigmoid(bbb))
        gdec = (-jnp.exp(a_log[0]) * jax.nn.softplus(baf.astype(jnp.float32) + dt_bias[0]),
                -jnp.exp(a_log[1]) * jax.nn.softplus(bab.astype(jnp.float32) + dt_bias[1]))
        return (aq, ak, av), (bq, bk, bv, beta, gdec, bz.reshape(bsz, t, B_HEADS, B_DV))

    (aql, akl, avl), (bql, bkl, bvl, betal, gl, zl) = prep(hl, True)
    (aqc, akc, avc), (bqc, bkc, bvc, betac, gcx, zc) = prep(hc, False)
    bsz, t = hl.shape[:2]
    ol_a = window_sink_attention(aql, akl, avl, akc, avc, sink)
    s0 = jnp.zeros((bsz, B_HEADS, B_DK, B_DV), jnp.float32)
    oc_f, sf = gated_delta_chunked(bqc, bkc, bvc, betac[0], gcx[0], s0)
    oc_b, sb = reverse_delta(bqc, bkc, bvc, betac[1], gcx[1], s0)
    ol_f, _ = gated_delta_chunked(bql, bkl, bvl, betal[0], gl[0], sf)
    ol_b, _ = reverse_delta(bql, bkl, bvl, betal[1], gl[1], sb)
    ol_b2 = (rms_norm(ol_f + ol_b, gnorm) * jax.nn.silu(zl)).reshape(bsz, t, B_VW)
    yl = jnp.concatenate([ol_a, ol_b2], axis=-1) @ w_out
    if not ctx_out:
        return yl, None
    lc = hc.shape[1]
    oc_a = ctx_attention(aqc, akc, avc, A_KV, sink)
    oc_b2 = (rms_norm(oc_f + oc_b, gnorm) * jax.nn.silu(zc)).reshape(bsz, lc, B_VW)
    yc = jnp.concatenate([oc_a, oc_b2], axis=-1) @ w_out
    return yl, yc


def full_attention_blocks(q, k, v, kc, vc):
    bsz, t = q.shape[:2]
    nb = t // Q_BLOCK
    g = C_HEADS // C_KV
    k_all = jnp.concatenate([kc, k], axis=1)
    v_all = jnp.concatenate([vc, v], axis=1)
    qb = jnp.moveaxis(q.reshape(bsz, nb, Q_BLOCK, C_KV, g, C_HD), 1, 0)

    def one_block(qblk):
        s = jnp.einsum('bqhgd,bkhd->bhgqk', qblk, k_all).astype(jnp.float32) * C_HD ** -0.5
        p = jax.nn.softmax(s, axis=-1).astype(v_all.dtype)
        return jnp.einsum('bhgqk,bkhd->bqhgd', p, v_all)

    o = lax.map(one_block, qb)
    return jnp.moveaxis(o, 0, 1).reshape(bsz, t, C_HEADS * C_HD)


def mixer_c(hl, hc, w_in, q_norm, k_norm, w_out, cos, sin, ctx_out):
    def prep(h, rope):
        bsz, t, _ = h.shape
        q, k, v = _split(h @ w_in, (C_HEADS * C_HD, C_KV * C_HD, C_KV * C_HD))
        q = rms_norm(q.reshape(bsz, t, C_HEADS, C_HD), q_norm)
        k = rms_norm(k.reshape(bsz, t, C_KV, C_HD), k_norm)
        v = v.reshape(bsz, t, C_KV, C_HD)
        if rope:
            q, k = apply_rope(q, cos, sin), apply_rope(k, cos, sin)
        return q, k, v

    ql, kl, vl = prep(hl, True)
    qc, kc, vc = prep(hc, False)
    yl = full_attention_blocks(ql, kl, vl, kc, vc) @ w_out
    if not ctx_out:
        return yl, None
    return yl, ctx_attention(qc, kc, vc, C_KV) @ w_out


def _mod(m, s):
    return m[:, 3 * s], m[:, 3 * s + 1], m[:, 3 * s + 2]


def ffn_sublayer(x, m, s, w_gu, w_down, g, b):
    shift, scale, gate = _mod(m, s)
    y = swiglu(x * (1 + scale) + shift, w_gu, w_down)
    return layer_norm(DEEP_ALPHA * x + FFN_HALF * gate * y, g, b)


def setup_inputs(seed: int = 0) -> dict:
    key = jax.random.key(seed)
    ks = jax.random.split(key, 24)
    f32 = jnp.float32
    nrm = lambda k, shape, sc: jax.random.normal(k, shape, f32) * sc
    dt = jnp.exp(jax.random.uniform(ks[13], (N_EVEN, 2, B_HEADS), f32, np.log(1e-3), np.log(1e-1)))
    return {
        'x': nrm(ks[0], (BATCH, SEQ, D_MODEL), 1.0),
        'c': nrm(ks[1], (BATCH, D_MODEL), 1.0),
        'ctx': nrm(ks[2], (BATCH, CTX_LEN, D_MODEL), 1.0),
        'c_ctx': nrm(ks[3], (D_MODEL,), 1.0),
        'ada_w': nrm(ks[4], (DEPTH, D_MODEL, N_MOD * D_MODEL), 0.5 * D_MODEL ** -0.5),
        'ada_b': nrm(ks[5], (DEPTH, N_MOD * D_MODEL), 0.02),
        'ln_g': 1.0 + nrm(ks[6], (DEPTH, N_SUB, D_MODEL), 0.02),
        'ln_b': nrm(ks[7], (DEPTH, N_SUB, D_MODEL), 0.02),
        'ffn_w_gu': nrm(ks[8], (DEPTH, 2, D_MODEL, 2 * D_FF), D_MODEL ** -0.5),
        'ffn_w_down': nrm(ks[9], (DEPTH, 2, D_FF, D_MODEL), DEEP_BETA * D_FF ** -0.5),
        'ab_w_in': nrm(ks[10], (N_EVEN, D_MODEL, AB_IN), D_MODEL ** -0.5),
        'ab_conv_w': nrm(ks[11], (N_EVEN, CONV_K, B_QKV), CONV_K ** -0.5),
        'ab_a_log': jnp.log(jax.random.uniform(ks[12], (N_EVEN, 2, B_HEADS), f32, 1.0, 16.0)),
        'ab_dt_bias': dt + jnp.log(-jnp.expm1(-dt)),
        'ab_gnorm': 1.0 + nrm(ks[14], (N_EVEN, B_DV), 0.02),
        'ab_sink': nrm(ks[15], (N_EVEN, A_HEADS), 0.5),
        'ab_w_out': nrm(ks[16], (N_EVEN, AB_OUT, D_MODEL), DEEP_BETA * AB_OUT ** -0.5),
        'c_w_in': nrm(ks[17], (N_ODD, D_MODEL, C_IN), D_MODEL ** -0.5),
        'c_q_norm': 1.0 + nrm(ks[18], (N_ODD, C_HD), 0.02),
        'c_k_norm': 1.0 + nrm(ks[19], (N_ODD, C_HD), 0.02),
        'c_w_out': nrm(ks[20], (N_ODD, C_OUT, D_MODEL), DEEP_BETA * C_OUT ** -0.5),
    }


def reference(x, c, ctx, c_ctx, ada_w, ada_b, ln_g, ln_b, ffn_w_gu, ffn_w_down, ab_w_in, ab_conv_w, ab_a_log,
              ab_dt_bias, ab_gnorm, ab_sink, ab_w_out, c_w_in, c_q_norm, c_k_norm, c_w_out):
    bsz, t, _ = x.shape
    rows = t // GRID_W
    cos_a, sin_a = axial_rope(rows, A_HD)
    cos_c, sin_c = axial_rope(rows, C_HD)
    xl, xc = x, ctx
    for l in range(DEPTH):
        ctx_out = l < DEPTH - 1
        m_l = (jax.nn.silu(c) @ ada_w[l] + ada_b[l]).reshape(bsz, N_MOD, 1, D_MODEL)
        m_c = (jax.nn.silu(c_ctx) @ ada_w[l] + ada_b[l]).reshape(1, N_MOD, 1, D_MODEL)
        xl = ffn_sublayer(xl, m_l, 0, ffn_w_gu[l, 0], ffn_w_down[l, 0], ln_g[l, 0], ln_b[l, 0])
        xc = ffn_sublayer(xc, m_c, 0, ffn_w_gu[l, 0], ffn_w_down[l, 0], ln_g[l, 0], ln_b[l, 0])
        sh_l, sc_l, gt_l = _mod(m_l, 1)
        sh_c, sc_c, gt_c = _mod(m_c, 1)
        hl = xl * (1 + sc_l) + sh_l
        hc = xc * (1 + sc_c) + sh_c
        i = l // 2
        if l % 2 == 0:
            yl, yc = mixer_ab(hl, hc, ab_w_in[i], ab_conv_w[i], ab_a_log[i], ab_dt_bias[i], ab_gnorm[i], ab_sink[i],
                              ab_w_out[i], cos_a, sin_a, ctx_out)
        else:
            yl, yc = mixer_c(hl, hc, c_w_in[i], c_q_norm[i], c_k_norm[i], c_w_out[i], cos_c, sin_c, ctx_out)
        xl = layer_norm(DEEP_ALPHA * xl + gt_l * yl, ln_g[l, 1], ln_b[l, 1])
        xl = ffn_sublayer(xl, m_l, 2, ffn_w_gu[l, 1], ffn_w_down[l, 1], ln_g[l, 2], ln_b[l, 2])
        if ctx_out:
            xc = layer_norm(DEEP_ALPHA * xc + gt_c * yc, ln_g[l, 1], ln_b[l, 1])
            xc = ffn_sublayer(xc, m_c, 2, ffn_w_gu[l, 1], ffn_w_down[l, 1], ln_g[l, 2], ln_b[l, 2])
    return xl
```

```cpp
#include <hip/hip_runtime.h>
#include <hip/hip_cooperative_groups.h>
#include <cstdint>
#include <cstdio>
namespace cg = cooperative_groups;

#define LAS __attribute__((address_space(3)))
#define DI __device__ __forceinline__
typedef unsigned short bf16_t;
typedef short bf16x8 __attribute__((ext_vector_type(8)));
typedef short s16x4 __attribute__((ext_vector_type(4)));
typedef float f32x2 __attribute__((ext_vector_type(2)));
typedef float f32x4 __attribute__((ext_vector_type(4)));
typedef float f32x16 __attribute__((ext_vector_type(16)));
typedef unsigned u32x2 __attribute__((ext_vector_type(2)));
typedef unsigned u32x4 __attribute__((ext_vector_type(4)));
typedef __bf16 bf16x2_t __attribute__((ext_vector_type(2)));

constexpr int DM = 1024, NB = 8, SEQ = 4096, CTXL = 256, SEGR = SEQ + CTXL, MROWS = NB * SEGR;
constexpr int DFF = 2816, NMODW = 9 * DM;
constexpr int ABP = 3072, CINW = 1536;
constexpr float ALPHA = 1.681792830507429f, LN_EPS = 1e-6f, LOG2E = 1.4426950408889634f;
constexpr int NCHUNK = 68, NITEM = NB * 4 * 2 * NCHUNK;

constexpr size_t MiB = 1u << 20;
constexpr size_t WS_MOD = 1 * MiB, WS_GATES = 3 * MiB, WS_W = 8 * MiB;
constexpr size_t W_GU0 = WS_W, W_DN0 = W_GU0 + 11 * MiB, W_GU1 = W_DN0 + 11 * MiB / 2, W_DN1 = W_GU1 + 11 * MiB, W_IN = W_DN1 + 11 * MiB / 2, W_OUT = W_IN + 6 * MiB;
constexpr size_t WS_X = 50 * MiB, WS_QKV = 186 * MiB, WS_Y = 390 * MiB, WS_BQKV = 458 * MiB, WS_YP = 560 * MiB, WS_END = 588 * MiB;
static_assert(W_OUT + 2 * MiB <= WS_X, "w map");
constexpr size_t ALT_GU1 = 72 * MiB, ALT_DN1 = ALT_GU1 + 11 * MiB, ALT_OUT = ALT_DN1 + 11 * MiB / 2;
constexpr int LDS_BYTES = 147456;

DI unsigned pk2(float lo, float hi) { f32x2 v = {lo, hi}; bf16x2_t b = __builtin_convertvector(v, bf16x2_t); return __builtin_bit_cast(unsigned, b); }
DI float bflo(unsigned w) { return __uint_as_float(w << 16); }
DI float bfhi(unsigned w) { return __uint_as_float(w & 0xffff0000u); }
DI float bf2f(short s) { return __uint_as_float(((unsigned)(unsigned short)s) << 16); }
DI float wave_sum(float v) {
#pragma unroll
    for (int o = 1; o < 64; o <<= 1) v += __shfl_xor(v, o);
    return v;
}
DI int opq(int x) { asm volatile("" : "+v"(x)); return x; }
DI int opqs(int x) { asm volatile("" : "+s"(x)); return x; }
DI float siluf(float x) { return x * __builtin_amdgcn_rcpf(1.f + __expf(-x)); }
#define LDS_WAIT() asm volatile("s_waitcnt lgkmcnt(0)" ::: "memory")
#define MFMA32(a, b, c) __builtin_amdgcn_mfma_f32_32x32x16_bf16((a), (b), (c), 0, 0, 0)
DI int crow(int r, int hi) { return (r & 3) + 8 * (r >> 2) + 4 * hi; }
DI bf16x8 pack8(const f32x16& x, int s) {
    u32x4 p; p[0] = pk2(x[8 * s], x[8 * s + 1]); p[1] = pk2(x[8 * s + 2], x[8 * s + 3]); p[2] = pk2(x[8 * s + 4], x[8 * s + 5]); p[3] = pk2(x[8 * s + 6], x[8 * s + 7]);
    return __builtin_bit_cast(bf16x8, p);
}
typedef short v4i16_t __attribute__((ext_vector_type(4)));
DI s16x4 trrd(const LAS unsigned char* p) { return __builtin_bit_cast(s16x4, __builtin_amdgcn_ds_read_tr16_b64_v4i16((LAS v4i16_t*)p)); }
DI bf16x8 cat8(s16x4 lo, s16x4 hi) { return __builtin_shufflevector(lo, hi, 0, 1, 2, 3, 4, 5, 6, 7); }
DI bf16x8 ld2x8(const LAS unsigned char* p) {
    s16x4 lo = *(const LAS s16x4*)p, hi = *(const LAS s16x4*)(p + 16); return cat8(lo, hi);
}

namespace pg8 {
constexpr int BM = 256, BK = 64, HALF = 128, HTB = HALF * BK * 2, NXCD = 8, WGM = 8;
DI int lds_byte(int r, int c) { const int st = (r >> 4) * 2 + (c >> 5), rr = r & 15, cc = c & 31, ob = rr * 64 + cc * 2; return st * 1024 + (ob ^ (((ob >> 9) & 1) << 5)); }
DI void stage_rc(int b, int& R, int& C) { const int st = b / 1024, sb = b % 1024, swz = sb ^ (((sb >> 9) & 1) << 5); R = (st >> 1) * 16 + swz / 64; C = (st & 1) * 32 + (swz % 64) / 2; }
DI int perm32(int rho) { const int n = rho >> 4, i = rho & 15; return 8 * (i >> 2) + 4 * n + (i & 3); }
struct Unit { int pm, pn, kt0, nkt, part; };
struct Gemm { const bf16_t* A; int lda; const bf16_t* Bt; int M, N, K; int skipctx; };
struct StaticOrder {
    int nM, nN, nwg, G, c, nt, skip;
    DI void init(int M, int N, int K, int G_, int c_, int skip_) { nM = M / BM; nN = N / BM; nwg = nM * nN; G = G_; c = c_; nt = K / BK; skip = skip_; }
    DI Unit get(int i) const {
        const long L = (long)i * G + c; const bool ok = L < nwg;
        int wgid = ok ? (int)L : 0; { const int q = nwg / NXCD, r = nwg % NXCD, xcd = wgid % NXCD, off = wgid / NXCD; wgid = (xcd < r ? xcd * (q + 1) : r * (q + 1) + (xcd - r) * q) + off; }
        const int nig = WGM * nN, gid = wgid / nig, fm = gid * WGM, gsz = (nM - fm) < WGM ? (nM - fm) : WGM;
        Unit u; const int pm = fm + ((wgid % nig) % gsz); u.pm = skip ? pm + (pm >> 4) + 1 : pm; u.pn = (wgid % nig) / gsz; u.kt0 = 0; u.nkt = ok ? nt : 0; u.part = 0; return u;
    }
};
constexpr int TAIL_ROW0 = 128 * 256;
struct TailSplitOrder {
    StaticOrder S; int nt; bool split;
    DI void init(int M, int N, int K, int G_, int c_, int skip_) { split = (!skip_ && G_ == 256 && M == 136 * 256 && N == 1024); S.init(split ? TAIL_ROW0 : M, N, K, G_, c_, skip_); nt = K / BK; }
    DI Unit get(int i) const {
        const Unit a = S.get(i);
        const bool p8 = nt >= 32;
        const int np = p8 ? 8 : 4, q = p8 ? S.c : (S.c & 127); const int part = q & (np - 1);
        const int base = (nt / np) & ~1, extra = (nt - np * base) / 2;
        const bool tail = split && i >= 2; const bool tok = (i == 2 && (p8 || S.c < 128));
        Unit u; u.pm = tail ? 128 + (p8 ? (q >> 5) : (q >> 4)) : a.pm; u.pn = tail ? (p8 ? (q >> 3) & 3 : (q >> 2) & 3) : a.pn; u.part = tail ? part : 0;
        u.kt0 = tail ? part * base + 2 * (part < extra ? part : extra) : 0; u.nkt = tail ? (tok ? base + (part < extra ? 2 : 0) : 0) : a.nkt; return u;
    }
};
struct EpiBf16 {
    static constexpr bool PERM = true;
    bf16_t* O; int ldc; bf16_t* OP;
    DI void operator()(const f32x4 (&acc)[2][2][4][2], const Unit& u, int wr, int wc, int fr, int fq) const {
        const int row0 = u.pm * BM + wr * 64 + fr; const int col0 = u.pn * BM + wc * 32 + 8 * fq;
        bf16_t* Ob = u.part ? OP + ((size_t)(u.part - 1) * 2048 - TAIL_ROW0) * ldc : O;
#pragma unroll
        for (int ai = 0; ai < 2; ++ai)
#pragma unroll
            for (int m = 0; m < 4; ++m) { bf16_t* rowp = Ob + (size_t)(row0 + ai * HALF + m * 16) * ldc + col0;
#pragma unroll
                for (int bj = 0; bj < 2; ++bj) { const f32x4 v0 = acc[ai][bj][m][0], v1 = acc[ai][bj][m][1];
                    u32x4 w; w.x = pk2(v0[0], v0[1]); w.y = pk2(v0[2], v0[3]); w.z = pk2(v1[0], v1[1]); w.w = pk2(v1[2], v1[3]);
                    *(u32x4*)(rowp + bj * HALF) = w; } }
    }
};
struct EpiSwiglu {
    static constexpr bool PERM = false;
    bf16_t* O;
    DI void operator()(const f32x4 (&acc)[2][2][4][2], const Unit& u, int wr, int wc, int fr, int fq) const {
        const int row0 = u.pm * BM + wr * 64 + fr; const int col0 = u.pn * 128 + wc * 32 + 8 * fq;
#pragma unroll
        for (int ai = 0; ai < 2; ++ai)
#pragma unroll
            for (int m = 0; m < 4; ++m) { bf16_t* rowp = O + (size_t)(row0 + ai * HALF + m * 16) * DFF + col0;
                float o[8];
#pragma unroll
                for (int bj = 0; bj < 2; ++bj) { const f32x4 g = acc[ai][bj][m][0], uu = acc[ai][bj][m][1];
#pragma unroll
                    for (int j = 0; j < 4; ++j) o[bj * 4 + j] = siluf(g[j]) * uu[j]; }
                u32x4 w; w.x = pk2(o[0], o[1]); w.y = pk2(o[2], o[3]); w.z = pk2(o[4], o[5]); w.w = pk2(o[6], o[7]);
                *(u32x4*)rowp = w; }
    }
};

template <class Sched, class Epi>
DI void gemm_phase(LAS unsigned char* lds, const Gemm g, int G, int cidx, const Epi& E) {
    Sched S; S.init(g.M, g.N, g.K, G, opqs(cidx), g.skipctx);
    const int tid = opq(threadIdx.x), wid = __builtin_amdgcn_readfirstlane(tid >> 6), lane = tid & 63, wr = wid >> 2, wc = wid & 3, fr = lane & 15, fq = lane >> 4;
    const int K = g.K, lda = g.lda;
    unsigned voffA[2], voffB[2];
#pragma unroll
    for (int i = 0; i < 2; ++i) { int R, C; stage_rc(tid * 16 + i * 8192, R, C); const int Rb = Epi::PERM ? ((R & ~31) + perm32(R & 31)) : R;
        voffA[i] = (unsigned)(R * lda + C) * 2u; voffB[i] = (unsigned)(Rb * K + C) * 2u; }
    const size_t kstep = (size_t)(BK * 2);
    const size_t hstepA = (size_t)HALF * lda * 2, tstepA = 2 * hstepA, hstepB = (size_t)HALF * K * 2, tstepB = 2 * hstepB;
    const unsigned ldsw = (unsigned)wid * 1024u;
    const int aoff = lds_byte(wr * 64 + fr, fq * 8), boff = lds_byte(wc * 32 + fr, fq * 8);
#define PG8_SA(b, h) (((b) * 2 + (h)) * HTB)
#define PG8_SB(b, h) ((4 + (b) * 2 + (h)) * HTB)
#define PG8_STAGE(bufoff, gbase, voff) do { _Pragma("unroll") for (int _i = 0; _i < 2; ++_i) \
        __builtin_amdgcn_global_load_lds((const unsigned*)((const char*)(gbase) + (voff)[_i]), (LAS unsigned*)(lds + (bufoff) + ldsw + _i * 8192), 16, 0, 0); } while (0)
#define PG8_LDA(dst, b, h) do { _Pragma("unroll") for (int m = 0; m < 4; ++m) _Pragma("unroll") for (int k = 0; k < 2; ++k) dst[m][k] = *(const LAS bf16x8*)(lds + PG8_SA(b, h) + aoff + m * 2048 + k * 1024); } while (0)
#define PG8_LDB(dst, b, h) do { _Pragma("unroll") for (int n = 0; n < 2; ++n) _Pragma("unroll") for (int k = 0; k < 2; ++k) dst[n][k] = *(const LAS bf16x8*)(lds + PG8_SB(b, h) + boff + n * 2048 + k * 1024); } while (0)
#define PG8_MMA(ai, bj, At, Bt) do { __builtin_amdgcn_s_setprio(1); _Pragma("unroll") for (int m = 0; m < 4; ++m) _Pragma("unroll") for (int n = 0; n < 2; ++n) _Pragma("unroll") for (int k = 0; k < 2; ++k) \
        acc[ai][bj][m][n] = __builtin_amdgcn_mfma_f32_16x16x32_bf16(Bt[n][k], At[m][k], acc[ai][bj][m][n], 0, 0, 0); __builtin_amdgcn_s_setprio(0); } while (0)
#define PG8_WAIT_V(n) asm volatile("s_waitcnt vmcnt(" #n ")" ::: "memory")
#define PG8_WAIT_L(n) asm volatile("s_waitcnt lgkmcnt(" #n ")" ::: "memory")
#define PG8_BAR __builtin_amdgcn_s_barrier()
#define PG8_SCHED __builtin_amdgcn_sched_barrier(0)
    Unit cur = S.get(0), nxt; int ui = 0;
    if (cur.nkt == 0) return;
    f32x4 acc[2][2][4][2];
#pragma unroll
    for (int a = 0; a < 2; ++a)
#pragma unroll
        for (int b = 0; b < 2; ++b)
#pragma unroll
            for (int m = 0; m < 4; ++m)
#pragma unroll
                for (int n = 0; n < 2; ++n) acc[a][b][m][n] = (f32x4){0.f, 0.f, 0.f, 0.f};
    bf16x8 At[4][2], B0[2][2], B1[2][2];
    const char* cA = (const char*)g.A + (size_t)cur.pm * tstepA + (size_t)cur.kt0 * kstep; const char* cB = (const char*)g.Bt + (size_t)cur.pn * tstepB + (size_t)cur.kt0 * kstep;
    PG8_STAGE(PG8_SB(0, 0), cB, voffB); PG8_STAGE(PG8_SB(0, 1), cB + hstepB, voffB); PG8_STAGE(PG8_SA(0, 0), cA, voffA); PG8_STAGE(PG8_SA(0, 1), cA + hstepA, voffA);
    if (wr == 1) PG8_BAR;
    PG8_WAIT_V(2); PG8_BAR;
    PG8_STAGE(PG8_SB(1, 0), cB + kstep, voffB); PG8_STAGE(PG8_SA(1, 0), cA + kstep, voffA); PG8_STAGE(PG8_SB(1, 1), cB + hstepB + kstep, voffB);
    PG8_WAIT_V(6); PG8_BAR;
    for (;;) {
        nxt = S.get(ui + 1); const bool has_next = nxt.nkt != 0;
        const char* nA = has_next ? (const char*)g.A + (size_t)nxt.pm * tstepA + (size_t)nxt.kt0 * kstep : cA; const char* nB = has_next ? (const char*)g.Bt + (size_t)nxt.pn * tstepB + (size_t)nxt.kt0 * kstep : cB;
        const int nt = cur.nkt;
        for (int t = 0; t < nt; t += 2) {
            const bool last = (t == nt - 2);
            const char* a1 = cA + (size_t)(t + 1) * kstep;
            const char* a2 = last ? nA : cA + (size_t)(t + 2) * kstep; const char* b2 = last ? nB : cB + (size_t)(t + 2) * kstep;
            const char* a3 = a2 + kstep; const char* b3 = b2 + kstep;
            PG8_LDB(B0, 0, 0); PG8_LDB(B1, 0, 1); PG8_SCHED; PG8_LDA(At, 0, 0); PG8_STAGE(PG8_SA(1, 1), a1 + hstepA, voffA);
            PG8_WAIT_V(8); PG8_WAIT_L(0); PG8_BAR; PG8_MMA(0, 0, At, B0); PG8_MMA(0, 1, At, B1); PG8_BAR; PG8_SCHED;
            PG8_LDA(At, 0, 1); PG8_STAGE(PG8_SB(0, 0), b2, voffB); PG8_STAGE(PG8_SB(0, 1), b2 + hstepB, voffB); PG8_STAGE(PG8_SA(0, 0), a2, voffA);
            PG8_WAIT_V(8); PG8_WAIT_L(0); PG8_BAR; PG8_MMA(1, 0, At, B0); PG8_MMA(1, 1, At, B1); PG8_BAR; PG8_SCHED;
            PG8_LDB(B0, 1, 0); PG8_LDB(B1, 1, 1); PG8_SCHED; PG8_LDA(At, 1, 0); PG8_STAGE(PG8_SA(0, 1), a2 + hstepA, voffA);
            PG8_WAIT_V(8); PG8_WAIT_L(0); PG8_BAR; PG8_MMA(0, 0, At, B0); PG8_MMA(0, 1, At, B1); PG8_BAR; PG8_SCHED;
            PG8_LDA(At, 1, 1); PG8_STAGE(PG8_SB(1, 0), b3, voffB); PG8_STAGE(PG8_SB(1, 1), b3 + hstepB, voffB); PG8_STAGE(PG8_SA(1, 0), a3, voffA);
            PG8_WAIT_V(8); PG8_WAIT_L(0); PG8_BAR; PG8_MMA(1, 0, At, B0); PG8_MMA(1, 1, At, B1); PG8_BAR; PG8_SCHED;
        }
        if (wr == 0) PG8_BAR;
        E(acc, cur, wr, wc, fr, fq);
        if (!has_next) break;
#pragma unroll
        for (int a = 0; a < 2; ++a)
#pragma unroll
            for (int b = 0; b < 2; ++b)
#pragma unroll
                for (int m = 0; m < 4; ++m)
#pragma unroll
                    for (int n = 0; n < 2; ++n) acc[a][b][m][n] = (f32x4){0.f, 0.f, 0.f, 0.f};
        cur = nxt; cA = nA; cB = nB; ++ui;
        if (wr == 1) PG8_BAR;
    }
    PG8_WAIT_V(0);
    PG8_BAR;
#undef PG8_SA
#undef PG8_SB
#undef PG8_STAGE
#undef PG8_LDA
#undef PG8_LDB
#undef PG8_MMA
#undef PG8_WAIT_V
#undef PG8_WAIT_L
#undef PG8_BAR
#undef PG8_SCHED
}
}

struct Params { const float* in[21]; float* out; unsigned char* ws; };
enum { I_X = 0, I_C, I_CTX, I_CCTX, I_ADAW, I_ADAB, I_LNG, I_LNB, I_WGU, I_WDN, I_ABIN, I_ABCONV, I_ALOG, I_DTB, I_GNORM, I_SINK, I_ABOUT, I_CIN, I_CQN, I_CKN, I_COUT };

template <int KIND> DI int dst_row(int n) {
    if (KIND == 1) { const int s = n >= DFF ? 1 : 0; const int a = n - s * DFF; const int pn = a >> 7, rem = a & 127; const int wc = rem >> 5, fq = (rem >> 3) & 3, bj = (rem >> 2) & 1, j = rem & 3;
        return pn * 256 + bj * 128 + wc * 32 + s * 16 + fq * 4 + j; }
    if (KIND == 2) { if (n < 512) return n; if (n < 2304) return n + 512; if (n < 2816) return n - 1792; return n; }
    return n;
}
template <int KIND> DI void tr_item(const float* W, int K, int N, bf16_t* WT, LAS float* scr, int item, int lane) {
    const int nblk = (N + 31) / 32, kb = item / nblk, nb = item % nblk, k0 = 64 * kb, n0 = 32 * nb;
    const int nl = lane & 31; const bool nok = (n0 + nl) < N;
    float wv[32];
#pragma unroll
    for (int i = 0; i < 32; ++i) { const int kk = 2 * i + (lane >> 5); wv[i] = nok ? W[(size_t)(k0 + kk) * N + n0 + nl] : 0.f; }
#pragma unroll
    for (int i = 0; i < 32; ++i) { const int kk = 2 * i + (lane >> 5); scr[kk * 33 + nl] = wv[i]; }
    LDS_WAIT();
    const int c = lane & 7;
#pragma unroll
    for (int j = 0; j < 4; ++j) { const int nn = (lane >> 3) + 8 * j; const LAS float* s = scr + (8 * c) * 33 + nn;
        u32x4 o; o.x = pk2(s[0 * 33], s[1 * 33]); o.y = pk2(s[2 * 33], s[3 * 33]); o.z = pk2(s[4 * 33], s[5 * 33]); o.w = pk2(s[6 * 33], s[7 * 33]);
        if (n0 + nn < N) *(u32x4*)(WT + (size_t)dst_row<KIND>(n0 + nn) * K + k0 + 8 * c) = o; }
    LDS_WAIT();
}
DI void convert_layer(const Params& P, int l, LAS unsigned char* lds, int gw, int NGW, int wave, int lane_, int part = 0, bool alt = false) {
    const int lane = opq(threadIdx.x) & 63;
    LAS float* scr = (LAS float*)(lds + wave * 16384);
    unsigned char* ws = P.ws; const int i2 = l >> 1;
    constexpr int I_GU = 16 * 176, I_DN = 44 * 32, I_AIN = 16 * 89, I_O = 16 * 32, I_CI = 16 * 48;
    const int n_in = (l & 1) ? I_CI : I_AIN;
    const int total = 2 * I_GU + 2 * I_DN + n_in + I_O;
    for (int it = gw; it < total; it += NGW) {
        int r = it;
        if (r < I_GU) { if (part != 2) tr_item<1>(P.in[I_WGU] + (size_t)(l * 2 + 0) * DM * 2 * DFF, DM, 2 * DFF, (bf16_t*)(ws + W_GU0), scr, r, lane); continue; } r -= I_GU;
        if (r < I_GU) { if (part != 1) tr_item<1>(P.in[I_WGU] + (size_t)(l * 2 + 1) * DM * 2 * DFF, DM, 2 * DFF, (bf16_t*)(alt ? (unsigned char*)P.out + ALT_GU1 : ws + W_GU1), scr, r, lane); continue; } r -= I_GU;
        if (r < I_DN) { if (part != 2) tr_item<0>(P.in[I_WDN] + (size_t)(l * 2 + 0) * DFF * DM, DFF, DM, (bf16_t*)(ws + W_DN0), scr, r, lane); continue; } r -= I_DN;
        if (r < I_DN) { if (part != 1) tr_item<0>(P.in[I_WDN] + (size_t)(l * 2 + 1) * DFF * DM, DFF, DM, (bf16_t*)(alt ? (unsigned char*)P.out + ALT_DN1 : ws + W_DN1), scr, r, lane); continue; } r -= I_DN;
        if (r < n_in) { if (part == 2) continue; if (l & 1) tr_item<0>(P.in[I_CIN] + (size_t)i2 * DM * CINW, DM, CINW, (bf16_t*)(ws + W_IN), scr, r, lane);
                        else tr_item<2>(P.in[I_ABIN] + (size_t)i2 * DM * 2832, DM, 2832, (bf16_t*)(ws + W_IN), scr, r, lane); continue; } r -= n_in;
        if (part != 1) tr_item<0>(((l & 1) ? P.in[I_COUT] : P.in[I_ABOUT]) + (size_t)i2 * DM * DM, DM, DM, (bf16_t*)(alt ? (unsigned char*)P.out + ALT_OUT : ws + W_OUT), scr, r, lane);
    }
    if (!(l & 1) && part != 2) {
        u32x4* z = (u32x4*)((bf16_t*)(ws + W_IN) + (size_t)2832 * DM); const int n16 = 240 * DM * 2 / 16;
        const unsigned z0 = (unsigned)opq(0); for (int i = gw * 64 + lane; i < n16; i += NGW * 64) z[i] = (u32x4){z0, z0, z0, z0};
    }
}

DI void mod_phase(const Params& P, unsigned char* lds, int tid_, int wave, int lane_) {
    const int tid = opq(threadIdx.x), lane = tid & 63;
    float* sc = (float*)lds; float* red = (float*)(lds + 36864);
    for (int idx = tid; idx < 9 * DM; idx += 512) { const int b9 = idx >> 10, k = idx & 1023; const float v = b9 < 8 ? P.in[I_C][b9 * DM + k] : P.in[I_CCTX][k]; sc[idx] = v / (1.f + __expf(-v)); }
    __syncthreads();
    float* MOD = (float*)(P.ws + WS_MOD);
    for (int item = blockIdx.x; item < 144; item += gridDim.x) {
        const int l = item / 36, cb = item % 36;
        const float* W = P.in[I_ADAW] + (size_t)l * DM * NMODW + cb * 256 + lane * 4;
        f32x4 acc[9];
#pragma unroll
        for (int b = 0; b < 9; ++b) acc[b] = (f32x4){0.f, 0.f, 0.f, 0.f};
#pragma unroll 8
        for (int kk = 0; kk < 128; ++kk) { const int k = wave * 128 + kk; const f32x4 w = *(const f32x4*)(W + (size_t)k * NMODW);
#pragma unroll
            for (int b = 0; b < 9; ++b) acc[b] += w * sc[b * DM + k]; }
#pragma unroll
        for (int b = 0; b < 9; ++b) *(f32x4*)&red[(wave * 9 + b) * 256 + lane * 4] = acc[b];
        __syncthreads();
        for (int o = tid; o < 9 * 256; o += 512) { const int b9 = o >> 8, cc = o & 255; float s = 0.f;
#pragma unroll
            for (int w = 0; w < 8; ++w) s += red[(w * 9 + b9) * 256 + cc];
            MOD[(size_t)(l * 9 + b9) * NMODW + cb * 256 + cc] = s + P.in[I_ADAB][l * NMODW + cb * 256 + cc]; }
        __syncthreads();
    }
}

DI const float* xin_row(const Params& P, int row) { const int b = row / SEGR, p = row % SEGR; return p < CTXL ? P.in[I_CTX] + (size_t)(b * CTXL + p) * DM : P.in[I_X] + (size_t)(b * SEQ + p - CTXL) * DM; }
DI void init_pass(const Params& P, int gw, int NGW, int lane_) {
    const int lane = opq(threadIdx.x) & 63;
    float* X = (float*)(P.ws + WS_X); bf16_t* H = (bf16_t*)P.out; const float* MOD = (const float*)(P.ws + WS_MOD);
    f32x4 xn[4];
#define IN_LOAD(r) do { const float* xr_ = xin_row(P, (r)) + lane * 4; _Pragma("unroll") for (int j = 0; j < 4; ++j) xn[j] = *(const f32x4*)(xr_ + j * 256); } while (0)
    if (gw < MROWS) IN_LOAD(gw);
    for (int row = gw; row < MROWS; row += NGW) {
        f32x4 x[4];
#pragma unroll
        for (int j = 0; j < 4; ++j) x[j] = xn[j];
        if (row + NGW < MROWS) IN_LOAD(row + NGW);
        const int b = row / SEGR, p = row % SEGR, b9 = p < CTXL ? 8 : b;
        const float* sh = MOD + (size_t)b9 * NMODW + lane * 4; const float* sc = sh + DM;
#pragma unroll
        for (int j = 0; j < 4; ++j) { const int col = j * 256 + lane * 4; const f32x4 s1 = *(const f32x4*)(sc + j * 256), s0 = *(const f32x4*)(sh + j * 256);
            *(f32x4*)(X + (size_t)row * DM + col) = x[j]; const f32x4 h = x[j] * (s1 + 1.f) + s0;
            u32x2 w; w.x = pk2(h[0], h[1]); w.y = pk2(h[2], h[3]); *(u32x2*)(H + (size_t)row * DM + col) = w; }
    }
#undef IN_LOAD
}
DI void ln_pass(const Params& P, int l, int s, float coef, int npart, int gw, int NGW, int lane_) {
    const int lane = opq(threadIdx.x) & 63;
    float* X = (float*)(P.ws + WS_X); bf16_t* H = (bf16_t*)P.out; const bf16_t* Y = (const bf16_t*)(P.ws + WS_Y); const float* MOD = (const float*)(P.ws + WS_MOD);
    const bool last = (l == 3 && s == 2), noctx = (l == 3 && s >= 1); const bool tailsplit = (NGW == 2048); const bf16_t* YPp = (const bf16_t*)(P.ws + WS_YP);
    const int nl = s < 2 ? l : l + 1, ns = s < 2 ? s + 1 : 0;
    const float* lg = P.in[I_LNG] + (l * 3 + s) * DM + lane * 4; const float* lb = P.in[I_LNB] + (l * 3 + s) * DM + lane * 4;
    const int RPW = (MROWS + NGW - 1) / NGW; const int nrows = tailsplit ? 17 : ((gw * RPW + RPW) < MROWS ? RPW : (MROWS - gw * RPW > 0 ? MROWS - gw * RPW : 0));
#define LN_ROW(k) (tailsplit ? ((k) < 16 ? gw * 16 + (k) : pg8::TAIL_ROW0 + gw) : gw * RPW + (k))
    f32x4 pg[4], plg[4], plb[4], psc[4], psh[4];
#pragma unroll
    for (int j = 0; j < 4; ++j) { plg[j] = *(const f32x4*)(lg + j * 256); plb[j] = *(const f32x4*)(lb + j * 256); }
    int cur_b9 = -1;
    f32x4 xn[4]; u32x2 yn[4];
    if (tailsplit && npart > 0 && !(noctx && ((pg8::TAIL_ROW0 + gw) % SEGR) < CTXL)) {
        bf16_t* yr = (bf16_t*)(P.ws + WS_Y) + (size_t)(pg8::TAIL_ROW0 + gw) * DM + lane * 4;
        f32x4 ys[4];
#pragma unroll
        for (int j = 0; j < 4; ++j) { const u32x2 e = *(const u32x2*)(yr + j * 256); ys[j] = (f32x4){bflo(e.x), bfhi(e.x), bflo(e.y), bfhi(e.y)}; }
#pragma unroll
        for (int pp = 0; pp < 7; ++pp) if (pp < npart) {
#pragma unroll
            for (int j = 0; j < 4; ++j) { const u32x2 e = *(const u32x2*)(YPp + ((size_t)pp * 2048 + gw) * DM + j * 256 + lane * 4); ys[j] += (f32x4){bflo(e.x), bfhi(e.x), bflo(e.y), bfhi(e.y)}; } }
#pragma unroll
        for (int j = 0; j < 4; ++j) { u32x2 w; w.x = pk2(ys[j][0], ys[j][1]); w.y = pk2(ys[j][2], ys[j][3]); *(u32x2*)(yr + j * 256) = w; }
    }
#define LN_LOAD(r) do { _Pragma("unroll") for (int j = 0; j < 4; ++j) { xn[j] = *(const f32x4*)(X + (size_t)(r) * DM + j * 256 + lane * 4); yn[j] = *(const u32x2*)(Y + (size_t)(r) * DM + j * 256 + lane * 4); } } while (0)
    if (nrows > 0) LN_LOAD(LN_ROW(0));
    for (int k = 0; k < nrows; ++k) {
        const int row = LN_ROW(k);
        f32x4 x[4]; u32x2 yw[4];
#pragma unroll
        for (int j = 0; j < 4; ++j) { x[j] = xn[j]; yw[j] = yn[j]; }
        if (k + 1 < nrows) { const int rn = LN_ROW(k + 1); LN_LOAD(rn); }
        const int b = row / SEGR, p = row % SEGR, b9 = p < CTXL ? 8 : b;
        if (noctx && p < CTXL) continue;
        if (b9 != cur_b9) { cur_b9 = b9;
            const float* gate = MOD + (size_t)(l * 9 + b9) * NMODW + (3 * s + 2) * DM + lane * 4;
            const float* sh = MOD + (size_t)((nl & 3) * 9 + b9) * NMODW + (3 * ns) * DM + lane * 4;
#pragma unroll
            for (int j = 0; j < 4; ++j) { pg[j] = *(const f32x4*)(gate + j * 256) * coef; psh[j] = *(const f32x4*)(sh + j * 256); psc[j] = *(const f32x4*)(sh + DM + j * 256) + 1.f; } }
        f32x4 v[4]; float sum = 0.f;
#pragma unroll
        for (int j = 0; j < 4; ++j) { const f32x4 y = (f32x4){bflo(yw[j].x), bfhi(yw[j].x), bflo(yw[j].y), bfhi(yw[j].y)};
            v[j] = x[j] * ALPHA + pg[j] * y; sum += (v[j][0] + v[j][1]) + (v[j][2] + v[j][3]); }
        const float mean = wave_sum(sum) * (1.f / DM); float s2 = 0.f;
#pragma unroll
        for (int j = 0; j < 4; ++j) { v[j] = v[j] - mean; s2 += (v[j][0] * v[j][0] + v[j][1] * v[j][1]) + (v[j][2] * v[j][2] + v[j][3] * v[j][3]); }
        const float rstd = 1.f / sqrtf(wave_sum(s2) * (1.f / DM) + LN_EPS);
#pragma unroll
        for (int j = 0; j < 4; ++j) { const int col = j * 256 + lane * 4; const f32x4 o = v[j] * rstd * plg[j] + plb[j];
            if (last) { *(f32x4*)(P.out + (size_t)(b * SEQ + p - CTXL) * DM + col) = o; }
            else { *(f32x4*)(X + (size_t)row * DM + col) = o; const f32x4 h = o * psc[j] + psh[j];
                u32x2 w; w.x = pk2(h[0], h[1]); w.y = pk2(h[2], h[3]); *(u32x2*)(H + (size_t)row * DM + col) = w; } }
    }
#undef LN_LOAD
#undef LN_ROW
}


DI void rope_cs(float (&cs)[8], float (&sn)[8], int f0, int nfreq, float pos_r, float pos_c) {
    const float l2t = 13.287712379549449f / (float)nfreq;
#pragma unroll
    for (int e = 0; e < 8; ++e) { const int f = f0 + e; const int fi = f % nfreq; const float inv = __builtin_amdgcn_exp2f(-(float)fi * l2t);
        float rev = (f < nfreq ? pos_r : pos_c) * inv * 0.15915494309189535f; rev -= rintf(rev);
        cs[e] = __builtin_amdgcn_cosf(rev); sn[e] = __builtin_amdgcn_sinf(rev); }
}
DI void cprep_pass(const Params& P, int i2, int gw, int NGW, int lane_) {
    const int lane = opq(threadIdx.x) & 63;
    bf16_t* QKV = (bf16_t*)(P.ws + WS_QKV);
    const int cj = lane & 15;
    const float qscale = 0.08838834764831845f * LOG2E;
    const int RPW = (MROWS + NGW - 1) / NGW; const int r0 = gw * RPW, r1 = (r0 + RPW) < MROWS ? (r0 + RPW) : MROWS;
    f32x4 nwq[2], nwk[2];
    nwq[0] = *(const f32x4*)(P.in[I_CQN] + i2 * 128 + cj * 8); nwq[1] = *(const f32x4*)(P.in[I_CQN] + i2 * 128 + cj * 8 + 4);
    nwk[0] = *(const f32x4*)(P.in[I_CKN] + i2 * 128 + cj * 8); nwk[1] = *(const f32x4*)(P.in[I_CKN] + i2 * 128 + cj * 8 + 4);
    u32x4 nx[3];
#define CP_LOAD(r) do { _Pragma("unroll") for (int i = 2; i < 3; ++i) nx[i] = (lane + 64 * i < 160) ? *(const u32x4*)(QKV + (size_t)(r) * CINW + (lane + 64 * i) * 8) : (u32x4){0u, 0u, 0u, 0u}; } while (0)
    if (r0 < r1) CP_LOAD(r0);
    for (int row = r0; row < r1; ++row) {
        u32x4 cx[3];
        cx[2] = nx[2];
        if (row + 1 < r1) CP_LOAD(row + 1);
        const int p = row % SEGR; const bool lat = p >= CTXL; const int t = p - CTXL;
        float cs[8], sn[8];
        if (lat) rope_cs(cs, sn, 8 * (cj & 7), 32, (float)(t >> 6), (float)(t & 63));
#pragma unroll
        for (int i = 2; i < 3; ++i) {
            const int ci = lane + 64 * i; const bool ok = ci < 160; const int head = ci >> 4;
            bf16_t* ptr = QKV + (size_t)row * CINW + ci * 8;
            const u32x4 w = cx[i];
            float x[8] = {bflo(w.x), bfhi(w.x), bflo(w.y), bfhi(w.y), bflo(w.z), bfhi(w.z), bflo(w.w), bfhi(w.w)};
            float ss = 0.f;
#pragma unroll
            for (int e = 0; e < 8; ++e) ss += x[e] * x[e];
            ss += __shfl_xor(ss, 1); ss += __shfl_xor(ss, 2); ss += __shfl_xor(ss, 4); ss += __shfl_xor(ss, 8);
            const float rinv = 1.f / sqrtf(ss * (1.f / 128.f) + LN_EPS);
            const f32x4 n0 = head < 8 ? nwq[0] : nwk[0], n1 = head < 8 ? nwq[1] : nwk[1];
#pragma unroll
            for (int e = 0; e < 4; ++e) { x[e] = x[e] * rinv * n0[e]; x[e + 4] = x[e + 4] * rinv * n1[e]; }
            float y[8];
#pragma unroll
            for (int e = 0; e < 8; ++e) { const float o = __shfl_xor(x[e], 8);
                y[e] = !lat ? x[e] : (cj < 8 ? x[e] * cs[e] - o * sn[e] : o * sn[e] + x[e] * cs[e]); }
            const float sc = head < 8 ? qscale : 1.f;
            if (ok) { u32x4 o; o.x = pk2(y[0] * sc, y[1] * sc); o.y = pk2(y[2] * sc, y[3] * sc); o.z = pk2(y[4] * sc, y[5] * sc); o.w = pk2(y[6] * sc, y[7] * sc); *(u32x4*)ptr = o; }
        }
    }
#undef CP_LOAD
}

template <int D>
DI void attn_unit(LAS unsigned char* lds, const bf16_t* Qp, bf16_t* Op, int ldq, const bf16_t* Kp, const bf16_t* Vp, int ldk,
                  int nt0, int p1, int nt1, bool win, int pq0, bool has_sink, float sink_l2, int tq0, int tid, int wave, int lane) {
    constexpr int PITCH = (D + 8) * 2, VPITCH = (D + 16) * 2, NCH = D / 64, DB = D / 32, DK = D / 16, CPR = D / 8;
    LAS unsigned char* Ks = lds; LAS unsigned char* Vs = lds + 64 * PITCH;
    const int qi = lane & 31, hi = lane >> 5, q4 = (lane & 15) >> 2, p4 = lane & 3, blk = (lane >> 4) & 1;
    bf16x8 qr[DK];
    { const bf16_t* qrow = Qp + (size_t)(32 * wave + qi) * ldq + 8 * hi;
#pragma unroll
      for (int dd = 0; dd < DK; ++dd) qr[dd] = *(const bf16x8*)(qrow + 16 * dd); }
    if (D == 64) {
        float qf[4][8];
#pragma unroll
        for (int dd = 0; dd < 4; ++dd)
#pragma unroll
            for (int e = 0; e < 8; ++e) qf[dd][e] = bf2f(qr[dd & (DK - 1)][e]);
        if (tq0 >= 0) { const int t = tq0 + 32 * wave + qi; const float pr = (float)(t >> 6), pc = (float)(t & 63);
#pragma unroll
            for (int dd = 0; dd < 2; ++dd) { float cs[8], sn[8]; rope_cs(cs, sn, 16 * dd + 8 * hi, 16, pr, pc);
#pragma unroll
                for (int e = 0; e < 8; ++e) { const float x1 = qf[dd][e], x2 = qf[dd + 2][e]; qf[dd][e] = x1 * cs[e] - x2 * sn[e]; qf[dd + 2][e] = x1 * sn[e] + x2 * cs[e]; } } }
        const float qs = 0.125f * LOG2E;
#pragma unroll
        for (int dd = 0; dd < 4; ++dd) { u32x4 w; w.x = pk2(qf[dd][0] * qs, qf[dd][1] * qs); w.y = pk2(qf[dd][2] * qs, qf[dd][3] * qs); w.z = pk2(qf[dd][4] * qs, qf[dd][5] * qs); w.w = pk2(qf[dd][6] * qs, qf[dd][7] * qs); qr[dd & (DK - 1)] = __builtin_bit_cast(bf16x8, w); }
    }
    f32x16 o[DB];
#pragma unroll
    for (int db = 0; db < DB; ++db)
#pragma unroll
        for (int r = 0; r < 16; ++r) o[db][r] = 0.f;
    float m = -1e30f, l = 0.f;
    const int NT = nt0 + nt1;
    u32x4 kreg[NCH], vreg[NCH];
#define ATT_LOADT(t) do { const int pt_ = (t) < nt0 ? 64 * (t) : p1 + 64 * ((t) - nt0); _Pragma("unroll") for (int i_ = 0; i_ < NCH; ++i_) { const int cid = tid + 512 * i_, row = cid / CPR, cc = cid % CPR; \
        kreg[i_] = *(const u32x4*)(Kp + (size_t)(pt_ + row) * ldk + cc * 8); vreg[i_] = *(const u32x4*)(Vp + (size_t)(pt_ + row) * ldk + cc * 8); } } while (0)
    ATT_LOADT(0);
    for (int t = 0; t < NT; ++t) {
        __syncthreads();
#pragma unroll
        for (int i = 0; i < NCH; ++i) { const int cid = tid + 512 * i, row = cid / CPR, cc = cid % CPR; *(LAS u32x4*)(Ks + row * PITCH + cc * 16) = kreg[i]; *(LAS u32x4*)(Vs + row * VPITCH + cc * 16) = vreg[i]; }
        __syncthreads();
        if (t + 1 < NT) ATT_LOADT(t + 1);
        f32x16 s0, s1;
#pragma unroll
        for (int r = 0; r < 16; ++r) { s0[r] = 0.f; s1[r] = 0.f; }
#pragma unroll
        for (int dd = 0; dd < DK; ++dd) { const bf16x8 a0 = *(const LAS bf16x8*)(Ks + qi * PITCH + (16 * dd + 8 * hi) * 2), a1 = *(const LAS bf16x8*)(Ks + (32 + qi) * PITCH + (16 * dd + 8 * hi) * 2);
            s0 = MFMA32(a0, qr[dd], s0); s1 = MFMA32(a1, qr[dd], s1); }
        if (win && t >= nt0) { const int pt = p1 + 64 * (t - nt0), pq = pq0 + 32 * wave + qi;
#pragma unroll
            for (int r = 0; r < 16; ++r) { const int dk = pq - (pt + crow(r, hi)); if (dk > 128 || dk < -128) s0[r] = -1e30f; if (dk - 32 > 128 || dk - 32 < -128) s1[r] = -1e30f; } }
        float mx = fmaxf(s0[0], s1[0]);
#pragma unroll
        for (int r = 1; r < 16; ++r) mx = fmaxf(mx, fmaxf(s0[r], s1[r]));
        mx = fmaxf(mx, __shfl_xor(mx, 32));
        const float mnew = fmaxf(m, mx), f = __builtin_amdgcn_exp2f(m - mnew); m = mnew;
        float ps = 0.f;
#pragma unroll
        for (int r = 0; r < 16; ++r) { s0[r] = __builtin_amdgcn_exp2f(s0[r] - m); s1[r] = __builtin_amdgcn_exp2f(s1[r] - m); ps += s0[r] + s1[r]; }
        l = l * f + ps;
#pragma unroll
        for (int db = 0; db < DB; ++db)
#pragma unroll
            for (int r = 0; r < 16; ++r) o[db][r] *= f;
        bf16x8 pw[4]; pw[0] = pack8(s0, 0); pw[1] = pack8(s0, 1); pw[2] = pack8(s1, 0); pw[3] = pack8(s1, 1);
#pragma unroll
        for (int db = 0; db < DB; ++db)
#pragma unroll
            for (int s4 = 0; s4 < 4; ++s4) { const LAS unsigned char* vp = Vs + (16 * s4 + 4 * hi + q4) * VPITCH + (32 * db + 16 * blk) * 2 + 8 * p4;
                const bf16x8 a = cat8(trrd(vp), trrd(vp + 8 * VPITCH)); o[db] = MFMA32(a, pw[s4], o[db]); }
    }
#undef ATT_LOADT
    float lt = l + __shfl_xor(l, 32); if (has_sink) lt += __builtin_amdgcn_exp2f(sink_l2 - m);
    const float inv = 1.f / lt;
    bf16_t* orow = Op + (size_t)(32 * wave + qi) * ldq + 4 * hi;
#pragma unroll
    for (int db = 0; db < DB; ++db)
#pragma unroll
        for (int g = 0; g < 4; ++g) { u32x2 w; w.x = pk2(o[db][4 * g] * inv, o[db][4 * g + 1] * inv); w.y = pk2(o[db][4 * g + 2] * inv, o[db][4 * g + 3] * inv); *(u32x2*)(orow + 32 * db + 8 * g) = w; }
}

namespace xat {
constexpr int D = 128, NW = 8, QBLK = 32, KVBLK = 64, LDQ = CINW, LDK = CINW, LDO = CINW;
constexpr float THRL = 11.5f;
constexpr size_t SHM_V = KVBLK * D * 2, SHM_K = KVBLK * D * 2, SHM_ATTN = 2 * SHM_V + 2 * SHM_K + NW * 64 * 4;
#define KSWZ(row, colB) ((row) * 256 + ((colB) ^ (((row) & 7) << 4)))
#define SBAR() __builtin_amdgcn_sched_barrier(0)
DI unsigned cvtpk(float lo, float hi) { unsigned r; asm volatile("v_cvt_pk_bf16_f32 %0, %1, %2" : "=v"(r) : "v"(lo), "v"(hi)); return r; }
DI void partialSM(f32x16& p0, f32x16& p1, float& m_reg, float& mn, float& alpha) {
  float pmax = p0[0];
#pragma unroll
  for (int r = 1; r < 16; ++r) pmax = fmaxf(pmax, p0[r]);
#pragma unroll
  for (int r = 0; r < 16; ++r) pmax = fmaxf(pmax, p1[r]);
  { auto rr = __builtin_amdgcn_permlane32_swap(__float_as_uint(pmax), __float_as_uint(pmax), false, false);
    pmax = fmaxf(__uint_as_float(rr[0]), __uint_as_float(rr[1])); }
  if (__builtin_expect(__all(pmax - m_reg <= THRL), 1)) { mn = m_reg; alpha = 1.f; }
  else { mn = fmaxf(m_reg, pmax); alpha = __builtin_amdgcn_exp2f(m_reg - mn); m_reg = mn; }
#pragma unroll
  for (int r = 0; r < 16; ++r) p0[r] = p0[r] - mn;
#pragma unroll
  for (int r = 0; r < 16; ++r) p1[r] = p1[r] - mn;
#pragma unroll
  for (int r = 0; r < 16; ++r) p0[r] = __builtin_amdgcn_exp2f(p0[r]);
}
DI void finishSM(f32x16& p0, f32x16& p1, float alpha, float& l_reg, bf16x8& pa0, bf16x8& pa1, bf16x8& pa2, bf16x8& pa3) {
#pragma unroll
  for (int r = 0; r < 16; ++r) p1[r] = __builtin_amdgcn_exp2f(p1[r]);
  float ps = 0;
#pragma unroll
  for (int r = 0; r < 16; ++r) ps += p0[r];
#pragma unroll
  for (int r = 0; r < 16; ++r) ps += p1[r];
  { auto rr = __builtin_amdgcn_permlane32_swap(__float_as_uint(ps), __float_as_uint(ps), false, false);
    ps = __uint_as_float(rr[0]) + __uint_as_float(rr[1]); }
  l_reg = l_reg * alpha + ps;
#define PK4(P, BASE, OUT) do { unsigned a0 = cvtpk(P[BASE + 0], P[BASE + 1]), a1 = cvtpk(P[BASE + 2], P[BASE + 3]);   \
    unsigned b0 = cvtpk(P[BASE + 4], P[BASE + 5]), b1 = cvtpk(P[BASE + 6], P[BASE + 7]);                              \
    auto r0 = __builtin_amdgcn_permlane32_swap(a0, b0, false, false); auto r1 = __builtin_amdgcn_permlane32_swap(a1, b1, false, false); \
    u32x4 w = {r0[0], r1[0], r0[1], r1[1]}; OUT = __builtin_bit_cast(bf16x8, w); } while (0)
  PK4(p0, 0, pa0); PK4(p0, 8, pa1); PK4(p1, 0, pa2); PK4(p1, 8, pa3);
#undef PK4
}
DI void qkt(f32x16& p0, f32x16& p1, const char* Ks, const bf16x8* qr, int r32, int hi) {
#pragma unroll
  for (int r = 0; r < 16; ++r) { p0[r] = 0.f; p1[r] = 0.f; }
#pragma unroll
  for (int d0 = 0; d0 < 8; ++d0) { const int cb = (d0 * 16 + hi * 8) * 2;
    const bf16x8 b0 = *reinterpret_cast<const bf16x8*>(Ks + KSWZ(r32, cb));
    const bf16x8 b1 = *reinterpret_cast<const bf16x8*>(Ks + KSWZ(32 + r32, cb));
    p0 = MFMA32(b0, qr[d0], p0); p1 = MFMA32(b1, qr[d0], p1); }
}
DI int v_st(int k, int c) { const int kk = (k & ~0xC) | ((k & 4) << 1) | ((k & 8) >> 1); return ((kk >> 3) * 4 + (c >> 5)) * 512 + ((kk & 7) * 32 + (c & 31)) * 2; }
DI int v_rd_base(int lane) { return ((lane & 3) << 3) | (((lane >> 2) & 3) << 6) | (((lane >> 4) & 1) << 5) | (((lane >> 5) & 1) << 8); }
constexpr int v_rd_off(int d0, int ks, int half) { return d0 * 512 + ks * 4096 + half * 2048; }
template <int OFF> DI s16x4 tr_read(int vb) { s16x4 r; asm volatile("ds_read_b64_tr_b16 %0, %1 offset:%2" : "=&v"(r) : "v"(vb), "i"(OFF) : "memory"); return r; }
template <int D0> DI void pv_one(f32x16& od, int vb, bf16x8 pa0, bf16x8 pa1, bf16x8 pa2, bf16x8 pa3) {
  const s16x4 l0 = tr_read<v_rd_off(D0, 0, 0)>(vb), h0 = tr_read<v_rd_off(D0, 0, 1)>(vb), l1 = tr_read<v_rd_off(D0, 1, 0)>(vb), h1 = tr_read<v_rd_off(D0, 1, 1)>(vb);
  const s16x4 l2 = tr_read<v_rd_off(D0, 2, 0)>(vb), h2 = tr_read<v_rd_off(D0, 2, 1)>(vb), l3 = tr_read<v_rd_off(D0, 3, 0)>(vb), h3 = tr_read<v_rd_off(D0, 3, 1)>(vb);
  asm volatile("s_waitcnt lgkmcnt(0)" ::: "memory"); SBAR();
  od = MFMA32(pa0, cat8(l0, h0), od); od = MFMA32(pa1, cat8(l1, h1), od); od = MFMA32(pa2, cat8(l2, h2), od); od = MFMA32(pa3, cat8(l3, h3), od);
}
DI void pv_d0(f32x16* o, int vb, bf16x8 pa0, bf16x8 pa1, bf16x8 pa2, bf16x8 pa3) {
  pv_one<0>(o[0], vb, pa0, pa1, pa2, pa3); pv_one<1>(o[1], vb, pa0, pa1, pa2, pa3); pv_one<2>(o[2], vb, pa0, pa1, pa2, pa3); pv_one<3>(o[3], vb, pa0, pa1, pa2, pa3);
}
DI void attn_dense_body(const bf16_t* Qb, const bf16_t* __restrict__ Kh, const bf16_t* __restrict__ Vh, bf16_t* Ob, int seq, char* lds, const float* qnw, int t0) {
  const int tid = opq(threadIdx.x), wid = tid >> 6, lane = tid & 63, r32 = lane & 31, hi = lane >> 5;
  char* V_lds = lds; char* K_lds = lds + 2 * SHM_V;
  float* ws = (float*)(lds + 2 * SHM_V + 2 * SHM_K) + wid * 64; float* li_l = ws; float* al_l = ws + 32;
  float m_reg = -1e30f, l_reg = 0; f32x16 o[4]; bf16x8 qr[8];
#pragma unroll
  for (int d = 0; d < 4; ++d)
#pragma unroll
    for (int r = 0; r < 16; ++r) o[d][r] = 0.f;
  const bf16_t* Qw = Qb + (long)(wid * QBLK + r32) * LDQ + hi * 8;
#pragma unroll
  for (int d0 = 0; d0 < 8; ++d0) qr[d0] = *reinterpret_cast<const bf16x8*>(Qw + d0 * 16);
  {
    float qf[8][8]; float ss = 0.f;
#pragma unroll
    for (int d0 = 0; d0 < 8; ++d0)
#pragma unroll
      for (int e = 0; e < 8; ++e) { qf[d0][e] = bf2f(qr[d0][e]); ss += qf[d0][e] * qf[d0][e]; }
    { auto rr = __builtin_amdgcn_permlane32_swap(__float_as_uint(ss), __float_as_uint(ss), false, false); ss = __uint_as_float(rr[0]) + __uint_as_float(rr[1]); }
    const float rinv = 1.f / sqrtf(ss * (1.f / 128.f) + LN_EPS);
#pragma unroll
    for (int d0 = 0; d0 < 8; ++d0) { const f32x4 w0 = *(const f32x4*)(qnw + 16 * d0 + 8 * hi), w1 = *(const f32x4*)(qnw + 16 * d0 + 8 * hi + 4);
#pragma unroll
      for (int e = 0; e < 4; ++e) { qf[d0][e] *= rinv * w0[e]; qf[d0][e + 4] *= rinv * w1[e]; } }
    if (t0 >= 0) { const int t = t0 + wid * QBLK + r32; const float pr = (float)(t >> 6), pc = (float)(t & 63);
#pragma unroll
      for (int d0 = 0; d0 < 4; ++d0) { float cs[8], sn[8]; rope_cs(cs, sn, 16 * d0 + 8 * hi, 32, pr, pc);
#pragma unroll
        for (int e = 0; e < 8; ++e) { const float x1 = qf[d0][e], x2 = qf[d0 + 4][e]; qf[d0][e] = x1 * cs[e] - x2 * sn[e]; qf[d0 + 4][e] = x1 * sn[e] + x2 * cs[e]; } } }
    const float qs = 0.08838834764831845f * LOG2E;
#pragma unroll
    for (int d0 = 0; d0 < 8; ++d0) { u32x4 w; w.x = pk2(qf[d0][0] * qs, qf[d0][1] * qs); w.y = pk2(qf[d0][2] * qs, qf[d0][3] * qs); w.z = pk2(qf[d0][4] * qs, qf[d0][5] * qs); w.w = pk2(qf[d0][6] * qs, qf[d0][7] * qs); qr[d0] = __builtin_bit_cast(bf16x8, w); }
  }
  const int sr = tid >> 4, sc = (tid & 15) * 8, vst0 = v_st(sr, sc), vst1 = v_st(32 + sr, sc);
  const int vb0 = (int)(uintptr_t)V_lds + v_rd_base(lane);
  struct { bf16x8 vs0, vs1, ks0, ks1; } sr_[2];
#define SLOAD(i, k0) do { sr_[i].vs0 = *reinterpret_cast<const bf16x8*>(&Vh[(long)((k0) + sr) * LDK + sc]); sr_[i].vs1 = *reinterpret_cast<const bf16x8*>(&Vh[(long)((k0) + 32 + sr) * LDK + sc]); \
    sr_[i].ks0 = *reinterpret_cast<const bf16x8*>(&Kh[(long)((k0) + sr) * LDK + sc]); sr_[i].ks1 = *reinterpret_cast<const bf16x8*>(&Kh[(long)((k0) + 32 + sr) * LDK + sc]); } while (0)
#define SWRITE(b, i) do { *(bf16x8*)(V_lds + (b) * SHM_V + vst0) = sr_[i].vs0; *(bf16x8*)(V_lds + (b) * SHM_V + vst1) = sr_[i].vs1; const int kc = sc * 2; \
    *(bf16x8*)(K_lds + (b) * SHM_K + KSWZ(sr, kc)) = sr_[i].ks0; *(bf16x8*)(K_lds + (b) * SHM_K + KSWZ(32 + sr, kc)) = sr_[i].ks1; } while (0)
#define SWAIT() asm volatile("s_waitcnt vmcnt(4)" ::: "memory")
#define RESC(a) do { if (__any((a) < 1.f)) { if (hi == 0) al_l[r32] = (a); asm volatile("s_waitcnt lgkmcnt(0)" ::: "memory"); \
    _Pragma("unroll") for (int d = 0; d < 4; ++d) _Pragma("unroll") for (int r = 0; r < 16; ++r) o[d][r] *= al_l[crow(r, hi)]; } } while (0)
  f32x16 pA0, pA1, pB0, pB1; float mnA, mnB, alA, alB; bf16x8 pa0, pa1, pa2, pa3; const int NT = seq / KVBLK;
  constexpr int SE = 0, SO = 1;
  SLOAD(SE, 0); asm volatile("s_waitcnt vmcnt(0)" ::: "memory"); SWRITE(0, SE); __syncthreads();
  qkt(pA0, pA1, K_lds, qr, r32, hi); partialSM(pA0, pA1, m_reg, mnA, alA);
  SLOAD(SO, KVBLK); if (2 < NT) SLOAD(SE, 2 * KVBLK);
  SWAIT(); SWRITE(1, SO); __syncthreads();
  for (int j = 1; j + 1 < NT; j += 2) {
    SBAR(); qkt(pB0, pB1, K_lds + SHM_K, qr, r32, hi);
    finishSM(pA0, pA1, alA, l_reg, pa0, pa1, pa2, pa3); SBAR();
    SLOAD(SO, (j + 2) * KVBLK); SBAR();
    pv_d0(o, vb0, pa0, pa1, pa2, pa3); partialSM(pB0, pB1, m_reg, mnB, alB);
    __syncthreads(); SWAIT(); SWRITE(0, SE);
    RESC(alB); __syncthreads();
    SBAR(); qkt(pA0, pA1, K_lds, qr, r32, hi);
    finishSM(pB0, pB1, alB, l_reg, pa0, pa1, pa2, pa3); SBAR();
    if (j + 3 < NT) SLOAD(SE, (j + 3) * KVBLK); SBAR();
    pv_d0(o, vb0 + (int)SHM_V, pa0, pa1, pa2, pa3); partialSM(pA0, pA1, m_reg, mnA, alA);
    __syncthreads(); SWAIT(); SWRITE(1, SO);
    RESC(alA); __syncthreads();
  }
  SBAR(); qkt(pB0, pB1, K_lds + SHM_K, qr, r32, hi);
  finishSM(pA0, pA1, alA, l_reg, pa0, pa1, pa2, pa3); SBAR();
  pv_d0(o, vb0, pa0, pa1, pa2, pa3); partialSM(pB0, pB1, m_reg, mnB, alB);
  __syncthreads(); RESC(alB);
  finishSM(pB0, pB1, alB, l_reg, pa0, pa1, pa2, pa3); SBAR();
  pv_d0(o, vb0 + (int)SHM_V, pa0, pa1, pa2, pa3);
  if (hi == 0) li_l[r32] = l_reg; asm volatile("s_waitcnt lgkmcnt(0)" ::: "memory");
  float rli[16];
#pragma unroll
  for (int r = 0; r < 16; ++r) rli[r] = __builtin_amdgcn_rcpf(li_l[crow(r, hi)]);
  bf16_t* Ow = Ob + (long)(wid * QBLK) * LDO;
#pragma unroll
  for (int r = 0; r < 16; ++r) { const int orow = crow(r, hi);
#pragma unroll
    for (int d0 = 0; d0 < 4; ++d0) Ow[(long)orow * LDO + d0 * 32 + r32] = (bf16_t)(cvtpk(o[d0][r] * rli[r], 0.f) & 0xffffu); }
  asm volatile("s_waitcnt vmcnt(0) lgkmcnt(0)" ::: "memory");
  __syncthreads();
#undef SLOAD
#undef SWRITE
#undef SWAIT
#undef RESC
}
#undef KSWZ
#undef SBAR
}

DI void attn_c_phase(const Params& P, char* glds, bool ctx_out, int i2, int tid_, int wave, int lane_) {
    const int tid = opq(threadIdx.x), lane = tid & 63;
    bf16_t* QKV = (bf16_t*)(P.ws + WS_QKV);
    const int nunits = 1024 + (ctx_out ? 64 : 0);
    const int G_ = gridDim.x; const int vcu = (G_ % 8 == 0) ? ((int)blockIdx.x % 8) * (G_ / 8) + (int)blockIdx.x / 8 : (int)blockIdx.x;
    for (int u = vcu; u < nunits; u += G_) {
        int b, h, qb;
        if (u < 1024) { qb = 1 + (u & 15); h = (u >> 4) & 7; b = u >> 7; } else { const int v = u - 1024; qb = 0; h = v & 7; b = v >> 3; }
        bf16_t* base = QKV + (size_t)b * SEGR * CINW;
        bf16_t* q = base + (size_t)(256 * qb) * CINW + h * 128;
        xat::attn_dense_body(q, base + 1024 + (h >> 2) * 128, base + 1280 + (h >> 2) * 128, q, qb ? 4352 : 256, glds, P.in[I_CQN] + i2 * 128, qb ? 256 * (qb - 1) : -1);
    }
}


DI void abprep_pass(const Params& P, int i2, LAS unsigned char* lds, int gw, int NGW, int lane_) {
    const int tid = opq(threadIdx.x), lane = tid & 63;
    bf16_t* QKV = (bf16_t*)(P.ws + WS_QKV); bf16_t* BQ = (bf16_t*)(P.ws + WS_BQKV); float* GT = (float*)(P.ws + WS_GATES);
    const int cj = lane & 7;
    LAS float* cwl = (LAS float*)lds;
    { const float* cw = P.in[I_ABCONV] + (size_t)i2 * 5 * 1536;
      for (int i = tid; i < 5 * 1536 / 4; i += 512) *(LAS f32x4*)(cwl + 4 * i) = *(const f32x4*)(cw + 4 * i); }
    __syncthreads();
    const int RPW = (MROWS + NGW - 1) / NGW; const int r0 = gw * RPW, r1 = (r0 + RPW) < MROWS ? (r0 + RPW) : MROWS;
    u32x4 nk; unsigned short ng = 0;
#define AB_LOADA(r) do { nk = *(const u32x4*)(QKV + (size_t)(r) * ABP + 1024 + (lane & 15) * 8); ng = QKV[(size_t)(r) * ABP + 2816 + (lane & 15)]; } while (0)
#define AB_LOADB(r, ci_) (*(const u32x4*)(QKV + (size_t)((r) < 0 ? 0 : ((r) >= MROWS ? MROWS - 1 : (r))) * ABP + 1280 + (ci_) * 8))
    const int hd = lane & 3, kind = (lane >> 2) & 3;
    const float dtb = P.in[I_DTB][i2 * 8 + (kind & 1) * 4 + hd], aexp = -__expf(P.in[I_ALOG][i2 * 8 + (kind & 1) * 4 + hd]);
    u32x4 w[3][8];
#pragma unroll
    for (int i = 0; i < 3; ++i)
#pragma unroll
        for (int k = 0; k < 7; ++k) w[i][k] = AB_LOADB(r0 - 2 + k, lane + 64 * i);
    if (r0 < r1) AB_LOADA(r0);
    for (int row = r0; row < r1; ++row) {
        const u32x4 wk = nk; const unsigned short wg = ng;
        if (row + 1 < r1) AB_LOADA(row + 1);
#pragma unroll
        for (int i = 0; i < 3; ++i) w[i][7] = AB_LOADB(row + 5, lane + 64 * i);
        const int p = row % SEGR; const bool lat = p >= CTXL; const int t = p - CTXL;
        { float cs[8], sn[8];
          if (lat) rope_cs(cs, sn, 8 * (cj & 3), 16, (float)(t >> 6), (float)(t & 63));
          float x[8] = {bflo(wk.x), bfhi(wk.x), bflo(wk.y), bfhi(wk.y), bflo(wk.z), bfhi(wk.z), bflo(wk.w), bfhi(wk.w)};
          float y[8];
#pragma unroll
          for (int e = 0; e < 8; ++e) { const float o = __shfl_xor(x[e], 4); y[e] = !lat ? x[e] : (cj < 4 ? x[e] * cs[e] - o * sn[e] : o * sn[e] + x[e] * cs[e]); }
          if (lane < 16) { u32x4 o; o.x = pk2(y[0], y[1]); o.y = pk2(y[2], y[3]); o.z = pk2(y[4], y[5]); o.w = pk2(y[6], y[7]); *(u32x4*)(QKV + (size_t)row * ABP + 1024 + lane * 8) = o;
              const float v = bf2f((short)wg); float r;
              if (kind < 2) r = 1.f / (1.f + __expf(-v));
              else { const float xx = v + dtb; const float ee = __expf(xx); const float sp = xx > 20.f ? xx : (ee < 0.01f ? ee * (1.f - ee * (0.5f - ee * 0.33333333f)) : __logf(1.f + ee)); r = aexp * sp; }
              GT[(size_t)row * 16 + lane] = r; } }
        const int plo = lat ? CTXL : 0, phi = lat ? SEGR : CTXL;
#pragma unroll
        for (int i = 0; i < 3; ++i) {
            const int ci = lane + 64 * i;
            float acc[8];
#pragma unroll
            for (int e = 0; e < 8; ++e) acc[e] = 0.f;
#pragma unroll
            for (int j = 0; j < 5; ++j) { const int pp = p + j - 2;
                if (pp >= plo && pp < phi) { const u32x4 ww = w[i][j]; const f32x4 c0 = *(const LAS f32x4*)(cwl + j * 1536 + ci * 8), c1 = *(const LAS f32x4*)(cwl + j * 1536 + ci * 8 + 4);
                    acc[0] += bflo(ww.x) * c0[0]; acc[1] += bfhi(ww.x) * c0[1]; acc[2] += bflo(ww.y) * c0[2]; acc[3] += bfhi(ww.y) * c0[3];
                    acc[4] += bflo(ww.z) * c1[0]; acc[5] += bfhi(ww.z) * c1[1]; acc[6] += bflo(ww.w) * c1[2]; acc[7] += bfhi(ww.w) * c1[3]; } }
            float ss = 0.f;
#pragma unroll
            for (int e = 0; e < 8; ++e) { acc[e] = siluf(acc[e]); ss += acc[e] * acc[e]; }
            ss += __shfl_xor(ss, 1); ss += __shfl_xor(ss, 2); ss += __shfl_xor(ss, 4); ss += __shfl_xor(ss, 8);
            const float sc = i == 2 ? 1.f : (1.f / sqrtf(ss + LN_EPS)) * (i == 0 ? 0.08838834764831845f : 1.f);
            u32x4 o; o.x = pk2(acc[0] * sc, acc[1] * sc); o.y = pk2(acc[2] * sc, acc[3] * sc); o.z = pk2(acc[4] * sc, acc[5] * sc); o.w = pk2(acc[6] * sc, acc[7] * sc);
            *(u32x4*)(BQ + (size_t)row * 1536 + ci * 8) = o;
#pragma unroll
            for (int k = 0; k < 7; ++k) w[i][k] = w[i][k + 1];
        }
    }
#undef AB_LOADA
#undef AB_LOADB
    __syncthreads();
}

constexpr int LSP = 68;
DI void tphase(const Params& P, LAS unsigned char* lds, int gw, int NGW, int wave, int lane_) {
    const int lane = opq(threadIdx.x) & 63;
    const bf16_t* BQ = (const bf16_t*)(P.ws + WS_BQKV); const float* GT = (const float*)(P.ws + WS_GATES);
    bf16_t* TB = (bf16_t*)(P.ws + WS_Y); bf16_t* AB = TB + (size_t)NITEM * 4096;
    LAS float* Ls = (LAS float*)(lds + wave * (64 * LSP * 4)); LAS float* gcs = (LAS float*)(lds + 8 * 64 * LSP * 4 + wave * 512); LAS float* bts = gcs + 64;
    LAS unsigned* ctr = (LAS unsigned*)(lds + 8 * 64 * LSP * 4 + 8 * 512);
    const int qi = lane & 31, hi = lane >> 5;
    const int G = NGW >> 3, ipw = (NITEM + G - 1) / G; const int it0 = (int)blockIdx.x * ipw; const int nit = (it0 + ipw <= NITEM) ? ipw : (NITEM > it0 ? NITEM - it0 : 0);
    if (threadIdx.x == 0) *ctr = 0u;
    __syncthreads();
    for (;;) {
        unsigned e = 0; if (lane == 0) e = atomicAdd((unsigned*)ctr, 1u);
        e = (unsigned)__builtin_amdgcn_readfirstlane((int)e);
        if ((int)e >= 2 * nit) break;
        const bool ahalf = (int)e >= nit; const int item = it0 + (ahalf ? (int)e - nit : (int)e);
        const int c = item % NCHUNK; int r_ = item / NCHUNK; const int dir = r_ & 1; r_ >>= 1; const int h = r_ & 3; const int b = r_ >> 2;
        const int mc = dir ? (c < 4 ? 3 - c : 71 - c) : c;
        const size_t row0 = (size_t)b * SEGR + 64 * mc;
#define ROWOF(i) (row0 + (dir ? 63 - (i) : (i)))
        const float beta = GT[ROWOF(lane) * 16 + 4 * dir + h]; float gc = GT[ROWOF(lane) * 16 + 8 + 4 * dir + h];
#pragma unroll
        for (int o = 1; o < 64; o <<= 1) { const float tt = __shfl_up(gc, o); if (lane >= o) gc += tt; }
        gcs[lane] = gc; bts[lane] = beta;
        bf16x8 kf[2][8];
#pragma unroll
        for (int I = 0; I < 2; ++I) { const bf16_t* rp = BQ + ROWOF(32 * I + qi) * 1536 + h * 128 + 8 * hi + 512;
#pragma unroll
            for (int dd = 0; dd < 8; ++dd) kf[I][dd] = *(const bf16x8*)(rp + 16 * dd); }
        LDS_WAIT();
        if (ahalf) {
            bf16_t* At = AB + (size_t)item * 4096;
            bf16x8 qf[2][8];
#pragma unroll
            for (int I = 0; I < 2; ++I) { const bf16_t* rp = BQ + ROWOF(32 * I + qi) * 1536 + h * 128 + 8 * hi;
#pragma unroll
                for (int dd = 0; dd < 8; ++dd) qf[I][dd] = *(const bf16x8*)(rp + 16 * dd); }
#pragma unroll
            for (int I = 0; I < 2; ++I) {
#pragma unroll
                for (int J = 0; J < 2; ++J) {
                    bf16_t* ap = At + (32 * I + 4 * hi) * 64 + 32 * J + qi;
                    if (J > I) {
#pragma unroll
                        for (int r = 0; r < 16; ++r) ap[((r & 3) + 8 * (r >> 2)) * 64] = 0;
                    } else {
                        f32x16 qk;
#pragma unroll
                        for (int r = 0; r < 16; ++r) qk[r] = 0.f;
#pragma unroll
                        for (int dd = 0; dd < 8; ++dd) qk = MFMA32(qf[I][dd], kf[J][dd], qk);
                        const int j = 32 * J + qi; const float gj = gcs[j];
#pragma unroll
                        for (int r = 0; r < 16; ++r) { const int i = 32 * I + crow(r, hi); const float dec = __expf(fminf(gcs[i] - gj, 0.f));
                            ap[((r & 3) + 8 * (r >> 2)) * 64] = (bf16_t)(pk2(i >= j ? qk[r] * dec : 0.f, 0.f) & 0xffffu); }
                    }
                    asm volatile("" ::: "memory");
                }
            }
        } else {
#pragma unroll
            for (int I = 0; I < 2; ++I)
#pragma unroll
                for (int J = 0; J <= I; ++J) {
                    f32x16 kk;
#pragma unroll
                    for (int r = 0; r < 16; ++r) kk[r] = 0.f;
#pragma unroll
                    for (int dd = 0; dd < 8; ++dd) kk = MFMA32(kf[I][dd], kf[J][dd], kk);
                    const int j = 32 * J + qi; const float gj = gcs[j];
#pragma unroll
                    for (int r = 0; r < 16; ++r) { const int i = 32 * I + crow(r, hi); const float dec = __expf(fminf(gcs[i] - gj, 0.f));
                        Ls[i * LSP + j] = i > j ? bts[i] * kk[r] * dec : 0.f; }
                    asm volatile("" ::: "memory");
                }
            LDS_WAIT();
            float tcol[64];
#pragma unroll
            for (int i = 0; i < 64; ++i) {
                float a = (lane == i) ? 1.f : 0.f, a1 = 0.f, a2 = 0.f, a3 = 0.f;
#pragma unroll
                for (int j4 = 0; j4 < i; j4 += 4) { const f32x4 Lr = *(const LAS f32x4*)(Ls + i * LSP + j4);
                    a -= Lr[0] * tcol[j4];
                    if (j4 + 1 < i) a1 -= Lr[1] * tcol[j4 + 1];
                    if (j4 + 2 < i) a2 -= Lr[2] * tcol[j4 + 2];
                    if (j4 + 3 < i) a3 -= Lr[3] * tcol[j4 + 3]; }
                tcol[i] = (a + a1) + (a2 + a3);
                asm volatile("" ::: "memory");
            }
            bf16_t* Tt = TB + (size_t)item * 4096;
#pragma unroll
            for (int i = 0; i < 64; ++i) Tt[i * 64 + lane] = (bf16_t)(pk2(tcol[i] * beta, 0.f) & 0xffffu);
        }
        LDS_WAIT();
#undef ROWOF
    }
    __syncthreads();
}

constexpr int SC_QS = 0, SC_KS = 17408, SC_VS = 34816, SC_TS = 52224, SC_AS = 61440, SC_EG = 70656, SC_EK = SC_EG + 256, SC_EL = SC_EG + 512, SC_BUF = 71680;
static_assert(2 * SC_BUF <= LDS_BYTES, "scan lds");
DI void scan_chain(const Params& P, LAS unsigned char* lds, int chain, int tid, int wave, int lane) {
    const int dir = chain & 1, h = (chain >> 1) & 3, b = chain >> 3;
    const bf16_t* BQ = (const bf16_t*)(P.ws + WS_BQKV); const float* GT = (const float*)(P.ws + WS_GATES);
    const bf16_t* TB = (const bf16_t*)(P.ws + WS_Y); const bf16_t* AB = TB + (size_t)NITEM * 4096;
    bf16_t* OB = (bf16_t*)P.out + (dir ? (size_t)MROWS * 512 : 0);
    const int ci = lane & 31, hi = lane >> 5, q4 = (lane & 15) >> 2, p4 = lane & 3, blk = (lane >> 4) & 1, cb = wave & 3;
    f32x16 S[4];
#pragma unroll
    for (int kb = 0; kb < 4; ++kb) {
#pragma unroll
        for (int r = 0; r < 16; ++r) S[kb][r] = 0.f; }
    if (wave >= 4) {
        u32x4 rq[4], rk[4], rv[4], rt[2], ra[2]; float graw = 0.f;
#define SC_LOAD(nn_) do { const int t2 = opq(tid) - 256; const int mc_ = dir ? ((nn_) < 4 ? 3 - (nn_) : 71 - (nn_)) : (nn_); const size_t row0_ = (size_t)b * SEGR + 64 * mc_; const size_t item_ = (size_t)chain * NCHUNK + (nn_); \
            _Pragma("unroll") for (int i = 0; i < 4; ++i) { const int cid = t2 + 256 * i, row = cid >> 4, cc = cid & 15, srow = dir ? 63 - row : row; const bf16_t* gp = BQ + (row0_ + srow) * 1536 + h * 128 + cc * 8; \
                rq[i] = *(const u32x4*)gp; rk[i] = *(const u32x4*)(gp + 512); rv[i] = *(const u32x4*)(gp + 1024); } \
            _Pragma("unroll") for (int i = 0; i < 2; ++i) { const int cid = t2 + 256 * i, row = cid >> 3, cc = cid & 7; rt[i] = *(const u32x4*)(TB + item_ * 4096 + row * 64 + cc * 8); ra[i] = *(const u32x4*)(AB + item_ * 4096 + row * 64 + cc * 8); } \
            if (wave == 4) { const int ln = t2 & 63; graw = GT[(row0_ + (dir ? 63 - ln : ln)) * 16 + 8 + 4 * dir + h]; } } while (0)
        SC_LOAD(0);
        for (int nn = 0; nn < NCHUNK; ++nn) {
            LAS unsigned char* B = lds + (nn & 1) * SC_BUF;
            const int t2 = opq(tid) - 256;
            if (wave == 4) { const int ln = t2 & 63; float gc = graw;
#pragma unroll
                for (int o = 1; o < 64; o <<= 1) { const float tt = __shfl_up(gc, o); if (ln >= o) gc += tt; }
                const float gl = __shfl(gc, 63);
                ((LAS float*)(B + SC_EG))[ln] = __expf(gc); ((LAS float*)(B + SC_EK))[ln] = __expf(gl - gc); if (ln == 63) ((LAS float*)(B + SC_EL))[0] = __expf(gc); }
#pragma unroll
            for (int i = 0; i < 4; ++i) { const int cid = t2 + 256 * i, row = cid >> 4, cc = cid & 15; *(LAS u32x4*)(B + SC_QS + row * 272 + cc * 16) = rq[i]; *(LAS u32x4*)(B + SC_KS + row * 272 + cc * 16) = rk[i]; *(LAS u32x4*)(B + SC_VS + row * 272 + cc * 16) = rv[i]; }
#pragma unroll
            for (int i = 0; i < 2; ++i) { const int cid = t2 + 256 * i, row = cid >> 3, cc = cid & 7; *(LAS u32x4*)(B + SC_TS + row * 144 + cc * 16) = rt[i]; *(LAS u32x4*)(B + SC_AS + row * 144 + cc * 16) = ra[i]; }
            if (nn + 1 < NCHUNK) SC_LOAD(nn + 1);
            __syncthreads();
        }
#undef SC_LOAD
        __syncthreads();
        return;
    }
    __syncthreads();
    for (int n = 0; n < NCHUNK; ++n) {
        {
            const LAS unsigned char* B = lds + (n & 1) * SC_BUF;
            const LAS unsigned char *QS = B + SC_QS, *KS = B + SC_KS, *VS = B + SC_VS, *TS = B + SC_TS, *AS = B + SC_AS; const LAS float *EG = (const LAS float*)(B + SC_EG), *EK = (const LAS float*)(B + SC_EK);
            const int mc = dir ? (n < 4 ? 3 - n : 71 - n) : n; const size_t row0 = (size_t)b * SEGR + 64 * mc;
            bf16x8 rfr[2][2], vnfr[2][2], vsfr[2][2], Sfr[4][2];
#pragma unroll
            for (int kb = 0; kb < 4; ++kb) { Sfr[kb][0] = pack8(S[kb], 0); Sfr[kb][1] = pack8(S[kb], 1); }
#pragma unroll
            for (int rb = 0; rb < 2; ++rb) { f32x16 acc;
#pragma unroll
                for (int r = 0; r < 16; ++r) acc[r] = 0.f;
#pragma unroll
                for (int kb = 0; kb < 4; ++kb)
#pragma unroll
                    for (int s = 0; s < 2; ++s) acc = MFMA32(ld2x8(KS + (32 * rb + ci) * 272 + (32 * kb + 16 * s + 4 * hi) * 2), Sfr[kb][s], acc);
                f32x16 rr;
#pragma unroll
                for (int g = 0; g < 4; ++g) { const s16x4 vv = trrd(VS + (32 * rb + 8 * g + 4 * hi + q4) * 272 + (32 * cb + 16 * blk) * 2 + 8 * p4); const f32x4 eg = *(const LAS f32x4*)(EG + 32 * rb + 8 * g + 4 * hi);
#pragma unroll
                    for (int j = 0; j < 4; ++j) rr[4 * g + j] = bf2f(vv[j]) - eg[j] * acc[4 * g + j]; }
                rfr[rb][0] = pack8(rr, 0); rfr[rb][1] = pack8(rr, 1); }
            asm volatile("" ::: "memory");
#pragma unroll
            for (int ob = 0; ob < 2; ++ob) { f32x16 acc;
#pragma unroll
                for (int r = 0; r < 16; ++r) acc[r] = 0.f;
#pragma unroll
                for (int rb = 0; rb <= ob; ++rb)
#pragma unroll
                    for (int s = 0; s < 2; ++s) acc = MFMA32(ld2x8(TS + (32 * ob + ci) * 144 + (32 * rb + 16 * s + 4 * hi) * 2), rfr[rb][s], acc);
                vnfr[ob][0] = pack8(acc, 0); vnfr[ob][1] = pack8(acc, 1);
#pragma unroll
                for (int g = 0; g < 4; ++g) { const f32x4 ek = *(const LAS f32x4*)(EK + 32 * ob + 8 * g + 4 * hi);
#pragma unroll
                    for (int j = 0; j < 4; ++j) acc[4 * g + j] *= ek[j]; }
                vsfr[ob][0] = pack8(acc, 0); vsfr[ob][1] = pack8(acc, 1); }
            asm volatile("" ::: "memory");
#pragma unroll
            for (int ob = 0; ob < 2; ++ob) { f32x16 acc;
#pragma unroll
                for (int r = 0; r < 16; ++r) acc[r] = 0.f;
#pragma unroll
                for (int kb = 0; kb < 4; ++kb)
#pragma unroll
                    for (int s = 0; s < 2; ++s) acc = MFMA32(ld2x8(QS + (32 * ob + ci) * 272 + (32 * kb + 16 * s + 4 * hi) * 2), Sfr[kb][s], acc);
#pragma unroll
                for (int g = 0; g < 4; ++g) { const f32x4 eg = *(const LAS f32x4*)(EG + 32 * ob + 8 * g + 4 * hi);
#pragma unroll
                    for (int j = 0; j < 4; ++j) acc[4 * g + j] *= eg[j]; }
#pragma unroll
                for (int rb = 0; rb <= ob; ++rb)
#pragma unroll
                    for (int s = 0; s < 2; ++s) acc = MFMA32(ld2x8(AS + (32 * ob + ci) * 144 + (32 * rb + 16 * s + 4 * hi) * 2), vnfr[rb][s], acc);
#pragma unroll
                for (int r = 0; r < 16; ++r) { const int i = 32 * ob + crow(r, hi); OB[(row0 + (dir ? 63 - i : i)) * 512 + h * 128 + 32 * cb + ci] = (bf16_t)(pk2(acc[r], 0.f) & 0xffffu); } }
            asm volatile("" ::: "memory");
            const float el = ((const LAS float*)(B + SC_EL))[0];
#pragma unroll
            for (int kb = 0; kb < 4; ++kb) {
#pragma unroll
                for (int r = 0; r < 16; ++r) S[kb][r] *= el;
#pragma unroll
                for (int rb = 0; rb < 2; ++rb)
#pragma unroll
                    for (int s = 0; s < 2; ++s) { const LAS unsigned char* kp = KS + (32 * rb + 16 * s + 4 * hi + q4) * 272 + (32 * kb + 16 * blk) * 2 + 8 * p4;
                        S[kb] = MFMA32(cat8(trrd(kp), trrd(kp + 8 * 272)), vsfr[rb][s], S[kb]); }
                asm volatile("" ::: "memory"); }
        }
        __syncthreads();
    }
}
DI void scan_attn_phase(const Params& P, LAS unsigned char* lds, int i2, int tid_, int wave, int lane_) {
    const int tid = opq(threadIdx.x), lane = tid & 63;
    const int G = gridDim.x;
    if ((int)blockIdx.x < 64) { scan_chain(P, lds, blockIdx.x, tid, wave, lane); return; }
    bf16_t* QKV = (bf16_t*)(P.ws + WS_QKV);
    for (int u = blockIdx.x - 64; u < 1088; u += G - 64) {
        const int qb = u % 17, h = (u / 17) & 7, b = u / 136;
        bf16_t* base = QKV + (size_t)b * SEGR * ABP; bf16_t* q = base + (size_t)(256 * qb) * ABP + h * 64;
        const bf16_t* K = base + 1024 + (h >> 2) * 64; const bf16_t* V = base + 1152 + (h >> 2) * 64;
        const float sk = P.in[I_SINK][i2 * 8 + h] * LOG2E;
        if (qb == 0) attn_unit<64>(lds, q, q, ABP, K, V, ABP, 4, 0, 0, false, 0, true, sk, -1, tid, wave, lane);
        else { const int pq0 = 256 * qb; const int lo = pq0 - 128 < CTXL ? CTXL : pq0 - 128; const int hi_ = pq0 + 384 > SEGR ? SEGR : pq0 + 384;
            attn_unit<64>(lds, q, q, ABP, K, V, ABP, 4, lo, (hi_ - lo) >> 6, true, pq0, true, sk, pq0 - CTXL, tid, wave, lane); }
    }
    __syncthreads();
    convert_layer(P, 2 * i2 + 1, lds, ((int)blockIdx.x - 64) * 8 + wave, (G - 64) * 8, wave, lane, 1);
    convert_layer(P, 2 * i2 + 1, lds, ((int)blockIdx.x - 64) * 8 + wave, (G - 64) * 8, wave, lane, 2, true);
}
DI void combine_pass(const Params& P, int i2, int gw, int NGW, int lane_) {
    const int lane = opq(threadIdx.x) & 63;
    bf16_t* QKV = (bf16_t*)(P.ws + WS_QKV); const bf16_t* OF = (const bf16_t*)P.out; const bf16_t* OBk = OF + (size_t)MROWS * 512;
    const f32x4 gn0 = *(const f32x4*)(P.in[I_GNORM] + i2 * 128 + (lane & 15) * 8), gn1 = *(const f32x4*)(P.in[I_GNORM] + i2 * 128 + (lane & 15) * 8 + 4);
    const int RPW = (MROWS + NGW - 1) / NGW; const int r0 = gw * RPW, r1 = (r0 + RPW) < MROWS ? (r0 + RPW) : MROWS;
    u32x4 na, nc, nz;
#define CB_LOAD(r) do { na = *(const u32x4*)(OF + (size_t)(r) * 512 + lane * 8); nc = *(const u32x4*)(OBk + (size_t)(r) * 512 + lane * 8); nz = *(const u32x4*)(QKV + (size_t)(r) * ABP + 512 + lane * 8); } while (0)
    if (r0 < r1) CB_LOAD(r0);
    for (int row = r0; row < r1; ++row) {
        const u32x4 a = na, c = nc, zw = nz;
        if (row + 1 < r1) CB_LOAD(row + 1);
        bf16_t* zp = QKV + (size_t)row * ABP + 512 + lane * 8;
        float x[8] = {bflo(a.x) + bflo(c.x), bfhi(a.x) + bfhi(c.x), bflo(a.y) + bflo(c.y), bfhi(a.y) + bfhi(c.y), bflo(a.z) + bflo(c.z), bfhi(a.z) + bfhi(c.z), bflo(a.w) + bflo(c.w), bfhi(a.w) + bfhi(c.w)};
        const float z[8] = {bflo(zw.x), bfhi(zw.x), bflo(zw.y), bfhi(zw.y), bflo(zw.z), bfhi(zw.z), bflo(zw.w), bfhi(zw.w)};
        float ss = 0.f;
#pragma unroll
        for (int e = 0; e < 8; ++e) ss += x[e] * x[e];
        ss += __shfl_xor(ss, 1); ss += __shfl_xor(ss, 2); ss += __shfl_xor(ss, 4); ss += __shfl_xor(ss, 8);
        const float rinv = 1.f / sqrtf(ss * (1.f / 128.f) + LN_EPS);
#pragma unroll
        for (int e = 0; e < 4; ++e) { x[e] = x[e] * rinv * gn0[e] * siluf(z[e]); x[e + 4] = x[e + 4] * rinv * gn1[e] * siluf(z[e + 4]); }
        u32x4 o; o.x = pk2(x[0], x[1]); o.y = pk2(x[2], x[3]); o.z = pk2(x[4], x[5]); o.w = pk2(x[6], x[7]); *(u32x4*)zp = o;
    }
#undef CB_LOAD
}


#define XB_TMO      128
#define XB_XCNT(j)  (256  + 64 * (j))
#define XB_XSUB(j)  (1280 + 64 * (j))
#define XB_XGEN(j)  (2304 + 64 * (j))
#define XB_TOP      3328
#define XB_TOPGEN   3392
#define XCD_BAR_WORDS 3456
#define XB_SPIN_CAP (1u << 18)
DI unsigned xb_ld(unsigned* p)              { return __hip_atomic_load(p, __ATOMIC_RELAXED, __HIP_MEMORY_SCOPE_AGENT); }
DI unsigned xb_add(unsigned* p, unsigned v) { return __hip_atomic_fetch_add(p, v, __ATOMIC_RELAXED, __HIP_MEMORY_SCOPE_AGENT); }
DI unsigned xb_xcc_id() { return (unsigned)__builtin_amdgcn_s_getreg((3 << 11) | 20) & 0xFu; }
#define XB_SPIN(cond, bar) do { unsigned _sp = 0; while (cond) { __builtin_amdgcn_s_sleep(1); \
    if ((++_sp & 255u) == 0u) { if (xb_ld(&(bar)[XB_TMO])) break; if (_sp > XB_SPIN_CAP) { atomicAdd(&(bar)[XB_TMO], 1u); break; } } } } while (0)
struct XcdBarrier { unsigned* bar; unsigned x; volatile LAS unsigned* st; };
DI XcdBarrier xcd_barrier_post(unsigned* bar, volatile LAS unsigned* st) {
    XcdBarrier b; b.bar = bar; b.x = (unsigned)__builtin_amdgcn_readfirstlane((int)xb_xcc_id()); b.st = st;
    if (threadIdx.x == 0) (void)xb_add(&bar[XB_XCNT(b.x)], 1u);
    return b;
}
DI void xcd_barrier_complete(unsigned* bar, unsigned x, unsigned& nloc, unsigned& nx) {
    const unsigned G = gridDim.x * gridDim.y * gridDim.z;
    unsigned sum, cnt, mine, sp = 0u;
    for (;;) {
        sum = 0u; cnt = 0u; mine = 0u;
#pragma unroll
        for (unsigned j = 0; j < 16; ++j) { const unsigned c = xb_ld(&bar[XB_XCNT(j)]); sum += c; cnt += (c > 0u) ? 1u : 0u; mine = (j == x) ? c : mine; }
        if (sum == G) break;
        __builtin_amdgcn_s_sleep(1);
        if ((++sp & 255u) == 0u) { if (xb_ld(&bar[XB_TMO])) break; if (sp > XB_SPIN_CAP) { atomicAdd(&bar[XB_TMO], 1u); break; } }
    }
    nloc = mine > 0u ? mine : 1u; nx = cnt > 0u ? cnt : 1u;
}
DI void xcd_barrier(const XcdBarrier& b) {
    asm volatile("s_waitcnt vmcnt(0)" ::: "memory");
    __syncthreads();
    if (threadIdx.x == 0) {
        unsigned* bar = b.bar; const unsigned bx = (unsigned)__builtin_amdgcn_readfirstlane((int)b.x);
        __builtin_amdgcn_s_waitcnt(0);
        unsigned nloc = b.st[0], nx = b.st[1];
        if (nloc == 0u) { xcd_barrier_complete(bar, bx, nloc, nx); b.st[0] = nloc; b.st[1] = nx; }
        const unsigned old = xb_add(&bar[XB_XSUB(bx)], 1u);
        const unsigned gen = old / nloc;
        if (old + 1u == (gen + 1u) * nloc) {
            __builtin_amdgcn_fence(__ATOMIC_RELEASE, "agent");
            asm volatile("s_waitcnt vmcnt(0)" ::: "memory");
            const unsigned og = xb_add(&bar[XB_TOP], 1u);
            const unsigned tg = og / nx;
            if (og + 1u == (tg + 1u) * nx) xb_add(&bar[XB_TOPGEN], 1u);
            else XB_SPIN(xb_ld(&bar[XB_TOPGEN]) == tg, bar);
            __builtin_amdgcn_fence(__ATOMIC_ACQUIRE, "agent");
            xb_add(&bar[XB_XGEN(bx)], 1u);
            asm volatile("s_waitcnt vmcnt(0)" ::: "memory");
        } else {
            XB_SPIN(xb_ld(&bar[XB_XGEN(bx)]) == gen, bar);
            __builtin_amdgcn_fence(__ATOMIC_ACQUIRE, "agent");
            asm volatile("s_waitcnt vmcnt(0)" ::: "memory");
        }
    }
    __syncthreads();
}

#define GSYNC(id) xcd_barrier(bar)
__global__ void __launch_bounds__(512, 2) mega(Params P) {
    extern __shared__ __attribute__((aligned(16))) unsigned char lds[];
    cg::grid_group grid = cg::this_grid();
    LAS unsigned char* l3 = (LAS unsigned char*)lds;
    const int wave = __builtin_amdgcn_readfirstlane(threadIdx.x >> 6);
    const int G = gridDim.x, gw = blockIdx.x * 8 + wave, NGW = G * 8; const int tid = 0, lane = 0;
    unsigned char* ws = P.ws;
    bf16_t* H = (bf16_t*)P.out; bf16_t* ACT = (bf16_t*)(ws + WS_QKV); bf16_t* QKV = ACT; bf16_t* Y = (bf16_t*)(ws + WS_Y); bf16_t* YP = (bf16_t*)(ws + WS_YP);

    { LAS unsigned* misc = (LAS unsigned*)(l3 + LDS_BYTES - 64); if (threadIdx.x < 16) misc[threadIdx.x] = 0u; }
    __syncthreads();
    const XcdBarrier bar = xcd_barrier_post((unsigned*)P.ws, (volatile LAS unsigned*)(l3 + LDS_BYTES - 64));
    mod_phase(P, lds, tid, wave, lane);
    __syncthreads();
    convert_layer(P, 0, l3, gw, NGW, wave, lane);
    grid.sync();
    GSYNC(10);
    init_pass(P, gw, NGW, lane);
    GSYNC(10);
    for (int l = 0; l < 4; ++l) {
        for (int half = 0; half < 2; ++half) {
            { const int sk = (l == 3 && half == 1) ? 1 : 0; pg8::Gemm g{H, DM, (const bf16_t*)(half ? ((l & 1) ? (unsigned char*)P.out + ALT_GU1 : ws + W_GU1) : ws + W_GU0), sk ? pg8::TAIL_ROW0 : MROWS, 2 * DFF, DM, sk}; pg8::EpiSwiglu E{ACT}; pg8::gemm_phase<pg8::StaticOrder>(l3, g, G, (int)blockIdx.x, E); }
            GSYNC(1);
            { const int sk = (l == 3 && half == 1) ? 1 : 0; pg8::Gemm g{ACT, DFF, (const bf16_t*)(half ? ((l & 1) ? (unsigned char*)P.out + ALT_DN1 : ws + W_DN1) : ws + W_DN0), sk ? pg8::TAIL_ROW0 : MROWS, DM, DFF, sk}; pg8::EpiBf16 E{Y, DM, YP}; pg8::gemm_phase<pg8::TailSplitOrder>(l3, g, G, (int)blockIdx.x, E); }
            GSYNC(2);
            ln_pass(P, l, half * 2, 0.5f, (l == 3 && half == 1) ? 0 : 7, gw, NGW, lane);
            if (half == 1 && l < 3 && (l & 1)) { __syncthreads(); convert_layer(P, l + 1, l3, gw, NGW, wave, lane, 0); }
            GSYNC(3);
            if (half == 0) {
                if (l & 1) {
                    { pg8::Gemm g{H, DM, (const bf16_t*)(ws + W_IN), MROWS, CINW, DM, 0}; pg8::EpiBf16 E{QKV, CINW, nullptr}; pg8::gemm_phase<pg8::StaticOrder>(l3, g, G, (int)blockIdx.x, E); }
                    GSYNC(4);
                    cprep_pass(P, l >> 1, gw, NGW, lane);
                    GSYNC(5);
                    attn_c_phase(P, (char*)lds, l < 3, l >> 1, tid, wave, lane);
                    GSYNC(6);
                    { const int sk = (l == 3) ? 1 : 0; pg8::Gemm g{QKV, CINW, (const bf16_t*)((unsigned char*)P.out + ALT_OUT), sk ? pg8::TAIL_ROW0 : MROWS, DM, DM, sk}; pg8::EpiBf16 E{Y, DM, YP}; pg8::gemm_phase<pg8::TailSplitOrder>(l3, g, G, (int)blockIdx.x, E); }
                    GSYNC(4);
                    ln_pass(P, l, 1, 1.f, (l == 3) ? 0 : 3, gw, NGW, lane);
                } else {
                    { pg8::Gemm g{H, DM, (const bf16_t*)(ws + W_IN), MROWS, ABP, DM, 0}; pg8::EpiBf16 E{QKV, ABP, nullptr}; pg8::gemm_phase<pg8::StaticOrder>(l3, g, G, (int)blockIdx.x, E); }
                    GSYNC(4);
                    abprep_pass(P, l >> 1, l3, gw, NGW, lane);
                    GSYNC(7);
#ifndef NO_TPHASE
                    tphase(P, l3, gw, NGW, wave, lane);
#endif
                    GSYNC(8);
#ifndef NO_SCAN
                    scan_attn_phase(P, l3, l >> 1, tid, wave, lane);
#endif
                    GSYNC(9);
                    combine_pass(P, l >> 1, gw, NGW, lane);
                    GSYNC(11);
                    { pg8::Gemm g{QKV, ABP, (const bf16_t*)(ws + W_OUT), MROWS, DM, DM, 0}; pg8::EpiBf16 E{Y, DM, YP}; pg8::gemm_phase<pg8::TailSplitOrder>(l3, g, G, (int)blockIdx.x, E); }
                    GSYNC(4);
                    ln_pass(P, l, 1, 1.f, 3, gw, NGW, lane);
                }
                GSYNC(3);
            }
        }
    }
}

extern "C" void kernel_launch(void* const* d_in, const int* in_sizes, int n_in, void* d_out, int out_size, void* d_ws, size_t ws_size, hipStream_t stream) {
    static int grid = 0;
    if (grid == 0) {
        int dev = 0, cus = 0, per_cu = 0;
        hipGetDevice(&dev); hipDeviceGetAttribute(&cus, hipDeviceAttributeMultiprocessorCount, dev);
        hipFuncSetAttribute((const void*)mega, hipFuncAttributeMaxDynamicSharedMemorySize, LDS_BYTES);
        hipOccupancyMaxActiveBlocksPerMultiprocessor(&per_cu, (const void*)mega, 512, LDS_BYTES);
        if (per_cu < 1) per_cu = 1;
        grid = cus * 1;
        if (ws_size < WS_END) fprintf(stderr, "kernel_launch: workspace too small: %zu < %zu\n", ws_size, (size_t)WS_END);
        (void)hipGetLastError();
    }
    (void)hipMemsetAsync(d_ws, 0, 16384, stream);
    Params p{};
    for (int i = 0; i < 21; ++i) p.in[i] = (const float*)d_in[i];
    p.out = (float*)d_out; p.ws = (unsigned char*)d_ws;
    void* args[] = {&p};
    hipError_t e = hipLaunchCooperativeKernel((const void*)mega, dim3(grid), dim3(512), args, LDS_BYTES, stream);
    if (e != hipSuccess) fprintf(stderr, "cooperative launch failed: %s (grid %d)\n", hipGetErrorString(e), grid);
}
```

```cpp
#include <hip/hip_runtime.h>
#include <hip/hip_cooperative_groups.h>
#include <cstdint>
#include <cstdio>
namespace cg = cooperative_groups;

#define LAS __attribute__((address_space(3)))
#define DI __device__ __forceinline__
typedef unsigned short bf16_t;
typedef short bf16x8 __attribute__((ext_vector_type(8)));
typedef short s16x4 __attribute__((ext_vector_type(4)));
typedef float f32x2 __attribute__((ext_vector_type(2)));
typedef float f32x4 __attribute__((ext_vector_type(4)));
typedef float f32x16 __attribute__((ext_vector_type(16)));
typedef unsigned u32x2 __attribute__((ext_vector_type(2)));
typedef unsigned u32x4 __attribute__((ext_vector_type(4)));
typedef __bf16 bf16x2_t __attribute__((ext_vector_type(2)));

constexpr int DM = 1024, NB = 8, SEQ = 4096, CTXL = 256, SEGR = SEQ + CTXL, MROWS = NB * SEGR;
constexpr int DFF = 2816, NMODW = 9 * DM;
constexpr int ABP = 3072, CINW = 1536;
constexpr float ALPHA = 1.681792830507429f, LN_EPS = 1e-6f, LOG2E = 1.4426950408889634f;
constexpr int NCHUNK = 68, NITEM = NB * 4 * 2 * NCHUNK;

constexpr size_t MiB = 1u << 20;
constexpr size_t WS_MOD = 1 * MiB, WS_GATES = 3 * MiB, WS_W = 8 * MiB;
constexpr size_t W_GU0 = WS_W, W_DN0 = W_GU0 + 11 * MiB, W_GU1 = W_DN0 + 11 * MiB / 2, W_DN1 = W_GU1 + 11 * MiB, W_IN = W_DN1 + 11 * MiB / 2, W_OUT = W_IN + 6 * MiB;
constexpr size_t WS_X = 50 * MiB, WS_QKV = 186 * MiB, WS_Y = 390 * MiB, WS_BQKV = 458 * MiB, WS_YP = 560 * MiB, WS_END = 588 * MiB;
static_assert(W_OUT + 2 * MiB <= WS_X, "w map");
constexpr int LDS_BYTES = 147456;

DI unsigned pk2(float lo, float hi) { f32x2 v = {lo, hi}; bf16x2_t b = __builtin_convertvector(v, bf16x2_t); return __builtin_bit_cast(unsigned, b); }
DI float bflo(unsigned w) { return __uint_as_float(w << 16); }
DI float bfhi(unsigned w) { return __uint_as_float(w & 0xffff0000u); }
DI float bf2f(short s) { return __uint_as_float(((unsigned)(unsigned short)s) << 16); }
DI float wave_sum(float v) {
#pragma unroll
    for (int o = 1; o < 64; o <<= 1) v += __shfl_xor(v, o);
    return v;
}
DI int opq(int x) { asm volatile("" : "+v"(x)); return x; }
DI int opqs(int x) { asm volatile("" : "+s"(x)); return x; }
DI float siluf(float x) { return x * __builtin_amdgcn_rcpf(1.f + __expf(-x)); }
#define LDS_WAIT() asm volatile("s_waitcnt lgkmcnt(0)" ::: "memory")
#define MFMA32(a, b, c) __builtin_amdgcn_mfma_f32_32x32x16_bf16((a), (b), (c), 0, 0, 0)
DI int crow(int r, int hi) { return (r & 3) + 8 * (r >> 2) + 4 * hi; }
DI bf16x8 pack8(const f32x16& x, int s) {
    u32x4 p; p[0] = pk2(x[8 * s], x[8 * s + 1]); p[1] = pk2(x[8 * s + 2], x[8 * s + 3]); p[2] = pk2(x[8 * s + 4], x[8 * s + 5]); p[3] = pk2(x[8 * s + 6], x[8 * s + 7]);
    return __builtin_bit_cast(bf16x8, p);
}
typedef short v4i16_t __attribute__((ext_vector_type(4)));
DI s16x4 trrd(const LAS unsigned char* p) { return __builtin_bit_cast(s16x4, __builtin_amdgcn_ds_read_tr16_b64_v4i16((LAS v4i16_t*)p)); }
DI bf16x8 cat8(s16x4 lo, s16x4 hi) { return __builtin_shufflevector(lo, hi, 0, 1, 2, 3, 4, 5, 6, 7); }
DI bf16x8 ld2x8(const LAS unsigned char* p) {
    s16x4 lo = *(const LAS s16x4*)p, hi = *(const LAS s16x4*)(p + 16); return cat8(lo, hi);
}

namespace pg8 {
constexpr int BM = 256, BK = 64, HALF = 128, HTB = HALF * BK * 2, NXCD = 8, WGM = 8;
DI int lds_byte(int r, int c) { const int st = (r >> 4) * 2 + (c >> 5), rr = r & 15, cc = c & 31, ob = rr * 64 + cc * 2; return st * 1024 + (ob ^ (((ob >> 9) & 1) << 5)); }
DI void stage_rc(int b, int& R, int& C) { const int st = b / 1024, sb = b % 1024, swz = sb ^ (((sb >> 9) & 1) << 5); R = (st >> 1) * 16 + swz / 64; C = (st & 1) * 32 + (swz % 64) / 2; }
DI int perm32(int rho) { const int n = rho >> 4, i = rho & 15; return 8 * (i >> 2) + 4 * n + (i & 3); }
struct Unit { int pm, pn, kt0, nkt, part; };
struct Gemm { const bf16_t* A; int lda; const bf16_t* Bt; int M, N, K; int skipctx; };
struct StaticOrder {
    int nM, nN, nwg, G, c, nt, skip;
    DI void init(int M, int N, int K, int G_, int c_, int skip_) { nM = M / BM; nN = N / BM; nwg = nM * nN; G = G_; c = c_; nt = K / BK; skip = skip_; }
    DI Unit get(int i) const {
        const long L = (long)i * G + c; const bool ok = L < nwg;
        int wgid = ok ? (int)L : 0; { const int q = nwg / NXCD, r = nwg % NXCD, xcd = wgid % NXCD, off = wgid / NXCD; wgid = (xcd < r ? xcd * (q + 1) : r * (q + 1) + (xcd - r) * q) + off; }
        const int nig = WGM * nN, gid = wgid / nig, fm = gid * WGM, gsz = (nM - fm) < WGM ? (nM - fm) : WGM;
        Unit u; const int pm = fm + ((wgid % nig) % gsz); u.pm = skip ? pm + (pm >> 4) + 1 : pm; u.pn = (wgid % nig) / gsz; u.kt0 = 0; u.nkt = ok ? nt : 0; u.part = 0; return u;
    }
};
constexpr int TAIL_ROW0 = 128 * 256;
struct TailSplitOrder {
    StaticOrder S; int nt; bool split;
    DI void init(int M, int N, int K, int G_, int c_, int skip_) { split = (!skip_ && G_ == 256 && M == 136 * 256 && N == 1024); S.init(split ? TAIL_ROW0 : M, N, K, G_, c_, skip_); nt = K / BK; }
    DI Unit get(int i) const {
        const Unit a = S.get(i);
        const bool p8 = nt >= 32;
        const int np = p8 ? 8 : 4, q = p8 ? S.c : (S.c & 127); const int part = q & (np - 1);
        const int base = (nt / np) & ~1, extra = (nt - np * base) / 2;
        const bool tail = split && i >= 2; const bool tok = (i == 2 && (p8 || S.c < 128));
        Unit u; u.pm = tail ? 128 + (p8 ? (q >> 5) : (q >> 4)) : a.pm; u.pn = tail ? (p8 ? (q >> 3) & 3 : (q >> 2) & 3) : a.pn; u.part = tail ? part : 0;
        u.kt0 = tail ? part * base + 2 * (part < extra ? part : extra) : 0; u.nkt = tail ? (tok ? base + (part < extra ? 2 : 0) : 0) : a.nkt; return u;
    }
};
struct EpiBf16 {
    static constexpr bool PERM = true;
    bf16_t* O; int ldc; bf16_t* OP;
    DI void operator()(const f32x4 (&acc)[2][2][4][2], const Unit& u, int wr, int wc, int fr, int fq) const {
        const int row0 = u.pm * BM + wr * 64 + fr; const int col0 = u.pn * BM + wc * 32 + 8 * fq;
        bf16_t* Ob = u.part ? OP + ((size_t)(u.part - 1) * 2048 - TAIL_ROW0) * ldc : O;
#pragma unroll
        for (int ai = 0; ai < 2; ++ai)
#pragma unroll
            for (int m = 0; m < 4; ++m) { bf16_t* rowp = Ob + (size_t)(row0 + ai * HALF + m * 16) * ldc + col0;
#pragma unroll
                for (int bj = 0; bj < 2; ++bj) { const f32x4 v0 = acc[ai][bj][m][0], v1 = acc[ai][bj][m][1];
                    u32x4 w; w.x = pk2(v0[0], v0[1]); w.y = pk2(v0[2], v0[3]); w.z = pk2(v1[0], v1[1]); w.w = pk2(v1[2], v1[3]);
                    *(u32x4*)(rowp + bj * HALF) = w; } }
    }
};
struct EpiSwiglu {
    static constexpr bool PERM = false;
    bf16_t* O;
    DI void operator()(const f32x4 (&acc)[2][2][4][2], const Unit& u, int wr, int wc, int fr, int fq) const {
        const int row0 = u.pm * BM + wr * 64 + fr; const int col0 = u.pn * 128 + wc * 32 + 8 * fq;
#pragma unroll
        for (int ai = 0; ai < 2; ++ai)
#pragma unroll
            for (int m = 0; m < 4; ++m) { bf16_t* rowp = O + (size_t)(row0 + ai * HALF + m * 16) * DFF + col0;
                float o[8];
#pragma unroll
                for (int bj = 0; bj < 2; ++bj) { const f32x4 g = acc[ai][bj][m][0], uu = acc[ai][bj][m][1];
#pragma unroll
                    for (int j = 0; j < 4; ++j) o[bj * 4 + j] = siluf(g[j]) * uu[j]; }
                u32x4 w; w.x = pk2(o[0], o[1]); w.y = pk2(o[2], o[3]); w.z = pk2(o[4], o[5]); w.w = pk2(o[6], o[7]);
                *(u32x4*)rowp = w; }
    }
};

template <class Sched, class Epi>
DI void gemm_phase(LAS unsigned char* lds, const Gemm g, int G, int cidx, const Epi& E) {
    Sched S; S.init(g.M, g.N, g.K, G, opqs(cidx), g.skipctx);
    const int tid = opq(threadIdx.x), wid = __builtin_amdgcn_readfirstlane(tid >> 6), lane = tid & 63, wr = wid >> 2, wc = wid & 3, fr = lane & 15, fq = lane >> 4;
    const int K = g.K, lda = g.lda;
    unsigned voffA[2], voffB[2];
#pragma unroll
    for (int i = 0; i < 2; ++i) { int R, C; stage_rc(tid * 16 + i * 8192, R, C); const int Rb = Epi::PERM ? ((R & ~31) + perm32(R & 31)) : R;
        voffA[i] = (unsigned)(R * lda + C) * 2u; voffB[i] = (unsigned)(Rb * K + C) * 2u; }
    const size_t kstep = (size_t)(BK * 2);
    const size_t hstepA = (size_t)HALF * lda * 2, tstepA = 2 * hstepA, hstepB = (size_t)HALF * K * 2, tstepB = 2 * hstepB;
    const unsigned ldsw = (unsigned)wid * 1024u;
    const int aoff = lds_byte(wr * 64 + fr, fq * 8), boff = lds_byte(wc * 32 + fr, fq * 8);
#define PG8_SA(b, h) (((b) * 2 + (h)) * HTB)
#define PG8_SB(b, h) ((4 + (b) * 2 + (h)) * HTB)
#define PG8_STAGE(bufoff, gbase, voff) do { _Pragma("unroll") for (int _i = 0; _i < 2; ++_i) \
        __builtin_amdgcn_global_load_lds((const unsigned*)((const char*)(gbase) + (voff)[_i]), (LAS unsigned*)(lds + (bufoff) + ldsw + _i * 8192), 16, 0, 0); } while (0)
#define PG8_LDA(dst, b, h) do { _Pragma("unroll") for (int m = 0; m < 4; ++m) _Pragma("unroll") for (int k = 0; k < 2; ++k) dst[m][k] = *(const LAS bf16x8*)(lds + PG8_SA(b, h) + aoff + m * 2048 + k * 1024); } while (0)
#define PG8_LDB(dst, b, h) do { _Pragma("unroll") for (int n = 0; n < 2; ++n) _Pragma("unroll") for (int k = 0; k < 2; ++k) dst[n][k] = *(const LAS bf16x8*)(lds + PG8_SB(b, h) + boff + n * 2048 + k * 1024); } while (0)
#define PG8_MMA(ai, bj, At, Bt) do { __builtin_amdgcn_s_setprio(1); _Pragma("unroll") for (int m = 0; m < 4; ++m) _Pragma("unroll") for (int n = 0; n < 2; ++n) _Pragma("unroll") for (int k = 0; k < 2; ++k) \
        acc[ai][bj][m][n] = __builtin_amdgcn_mfma_f32_16x16x32_bf16(Bt[n][k], At[m][k], acc[ai][bj][m][n], 0, 0, 0); __builtin_amdgcn_s_setprio(0); } while (0)
#define PG8_WAIT_V(n) asm volatile("s_waitcnt vmcnt(" #n ")" ::: "memory")
#define PG8_WAIT_L(n) asm volatile("s_waitcnt lgkmcnt(" #n ")" ::: "memory")
#define PG8_BAR __builtin_amdgcn_s_barrier()
#define PG8_SCHED __builtin_amdgcn_sched_barrier(0)
    Unit cur = S.get(0), nxt; int ui = 0;
    if (cur.nkt == 0) return;
    f32x4 acc[2][2][4][2];
#pragma unroll
    for (int a = 0; a < 2; ++a)
#pragma unroll
        for (int b = 0; b < 2; ++b)
#pragma unroll
            for (int m = 0; m < 4; ++m)
#pragma unroll
                for (int n = 0; n < 2; ++n) acc[a][b][m][n] = (f32x4){0.f, 0.f, 0.f, 0.f};
    bf16x8 At[4][2], B0[2][2], B1[2][2];
    const char* cA = (const char*)g.A + (size_t)cur.pm * tstepA + (size_t)cur.kt0 * kstep; const char* cB = (const char*)g.Bt + (size_t)cur.pn * tstepB + (size_t)cur.kt0 * kstep;
    PG8_STAGE(PG8_SB(0, 0), cB, voffB); PG8_STAGE(PG8_SB(0, 1), cB + hstepB, voffB); PG8_STAGE(PG8_SA(0, 0), cA, voffA); PG8_STAGE(PG8_SA(0, 1), cA + hstepA, voffA);
    if (wr == 1) PG8_BAR;
    PG8_WAIT_V(2); PG8_BAR;
    PG8_STAGE(PG8_SB(1, 0), cB + kstep, voffB); PG8_STAGE(PG8_SA(1, 0), cA + kstep, voffA); PG8_STAGE(PG8_SB(1, 1), cB + hstepB + kstep, voffB);
    PG8_WAIT_V(6); PG8_BAR;
    for (;;) {
        nxt = S.get(ui + 1); const bool has_next = nxt.nkt != 0;
        const char* nA = has_next ? (const char*)g.A + (size_t)nxt.pm * tstepA + (size_t)nxt.kt0 * kstep : cA; const char* nB = has_next ? (const char*)g.Bt + (size_t)nxt.pn * tstepB + (size_t)nxt.kt0 * kstep : cB;
        const int nt = cur.nkt;
        for (int t = 0; t < nt; t += 2) {
            const bool last = (t == nt - 2);
            const char* a1 = cA + (size_t)(t + 1) * kstep;
            const char* a2 = last ? nA : cA + (size_t)(t + 2) * kstep; const char* b2 = last ? nB : cB + (size_t)(t + 2) * kstep;
            const char* a3 = a2 + kstep; const char* b3 = b2 + kstep;
            PG8_LDB(B0, 0, 0); PG8_LDB(B1, 0, 1); PG8_SCHED; PG8_LDA(At, 0, 0); PG8_STAGE(PG8_SA(1, 1), a1 + hstepA, voffA);
            PG8_WAIT_V(8); PG8_WAIT_L(0); PG8_BAR; PG8_MMA(0, 0, At, B0); PG8_MMA(0, 1, At, B1); PG8_BAR; PG8_SCHED;
            PG8_LDA(At, 0, 1); PG8_STAGE(PG8_SB(0, 0), b2, voffB); PG8_STAGE(PG8_SB(0, 1), b2 + hstepB, voffB); PG8_STAGE(PG8_SA(0, 0), a2, voffA);
            PG8_WAIT_V(8); PG8_WAIT_L(0); PG8_BAR; PG8_MMA(1, 0, At, B0); PG8_MMA(1, 1, At, B1); PG8_BAR; PG8_SCHED;
            PG8_LDB(B0, 1, 0); PG8_LDB(B1, 1, 1); PG8_SCHED; PG8_LDA(At, 1, 0); PG8_STAGE(PG8_SA(0, 1), a2 + hstepA, voffA);
            PG8_WAIT_V(8); PG8_WAIT_L(0); PG8_BAR; PG8_MMA(0, 0, At, B0); PG8_MMA(0, 1, At, B1); PG8_BAR; PG8_SCHED;
            PG8_LDA(At, 1, 1); PG8_STAGE(PG8_SB(1, 0), b3, voffB); PG8_STAGE(PG8_SB(1, 1), b3 + hstepB, voffB); PG8_STAGE(PG8_SA(1, 0), a3, voffA);
            PG8_WAIT_V(8); PG8_WAIT_L(0); PG8_BAR; PG8_MMA(1, 0, At, B0); PG8_MMA(1, 1, At, B1); PG8_BAR; PG8_SCHED;
        }
        if (wr == 0) PG8_BAR;
        E(acc, cur, wr, wc, fr, fq);
        if (!has_next) break;
#pragma unroll
        for (int a = 0; a < 2; ++a)
#pragma unroll
            for (int b = 0; b < 2; ++b)
#pragma unroll
                for (int m = 0; m < 4; ++m)
#pragma unroll
                    for (int n = 0; n < 2; ++n) acc[a][b][m][n] = (f32x4){0.f, 0.f, 0.f, 0.f};
        cur = nxt; cA = nA; cB = nB; ++ui;
        if (wr == 1) PG8_BAR;
    }
    PG8_WAIT_V(0);
    PG8_BAR;
#undef PG8_SA
#undef PG8_SB
#undef PG8_STAGE
#undef PG8_LDA
#undef PG8_LDB
#undef PG8_MMA
#undef PG8_WAIT_V
#undef PG8_WAIT_L
#undef PG8_BAR
#undef PG8_SCHED
}
}

struct Params { const float* in[21]; float* out; unsigned char* ws; };
enum { I_X = 0, I_C, I_CTX, I_CCTX, I_ADAW, I_ADAB, I_LNG, I_LNB, I_WGU, I_WDN, I_ABIN, I_ABCONV, I_ALOG, I_DTB, I_GNORM, I_SINK, I_ABOUT, I_CIN, I_CQN, I_CKN, I_COUT };

template <int KIND> DI int dst_row(int n) {
    if (KIND == 1) { const int s = n >= DFF ? 1 : 0; const int a = n - s * DFF; const int pn = a >> 7, rem = a & 127; const int wc = rem >> 5, fq = (rem >> 3) & 3, bj = (rem >> 2) & 1, j = rem & 3;
        return pn * 256 + bj * 128 + wc * 32 + s * 16 + fq * 4 + j; }
    if (KIND == 2) { if (n < 512) return n; if (n < 2304) return n + 512; if (n < 2816) return n - 1792; return n; }
    return n;
}
template <int KIND> DI void tr_item(const float* W, int K, int N, bf16_t* WT, LAS float* scr, int item, int lane) {
    const int nblk = (N + 31) / 32, kb = item / nblk, nb = item % nblk, k0 = 64 * kb, n0 = 32 * nb;
    const int nl = lane & 31; const bool nok = (n0 + nl) < N;
    float wv[32];
#pragma unroll
    for (int i = 0; i < 32; ++i) { const int kk = 2 * i + (lane >> 5); wv[i] = nok ? W[(size_t)(k0 + kk) * N + n0 + nl] : 0.f; }
#pragma unroll
    for (int i = 0; i < 32; ++i) { const int kk = 2 * i + (lane >> 5); scr[kk * 33 + nl] = wv[i]; }
    LDS_WAIT();
    const int c = lane & 7;
#pragma unroll
    for (int j = 0; j < 4; ++j) { const int nn = (lane >> 3) + 8 * j; const LAS float* s = scr + (8 * c) * 33 + nn;
        u32x4 o; o.x = pk2(s[0 * 33], s[1 * 33]); o.y = pk2(s[2 * 33], s[3 * 33]); o.z = pk2(s[4 * 33], s[5 * 33]); o.w = pk2(s[6 * 33], s[7 * 33]);
        if (n0 + nn < N) *(u32x4*)(WT + (size_t)dst_row<KIND>(n0 + nn) * K + k0 + 8 * c) = o; }
    LDS_WAIT();
}
DI void convert_layer(const Params& P, int l, LAS unsigned char* lds, int gw, int NGW, int wave, int lane_, int part = 0) {
    const int lane = opq(threadIdx.x) & 63;
    LAS float* scr = (LAS float*)(lds + wave * 16384);
    unsigned char* ws = P.ws; const int i2 = l >> 1;
    constexpr int I_GU = 16 * 176, I_DN = 44 * 32, I_AIN = 16 * 89, I_O = 16 * 32, I_CI = 16 * 48;
    const int n_in = (l & 1) ? I_CI : I_AIN;
    const int total = 2 * I_GU + 2 * I_DN + n_in + I_O;
    for (int it = gw; it < total; it += NGW) {
        int r = it;
        if (r < I_GU) { if (part != 2) tr_item<1>(P.in[I_WGU] + (size_t)(l * 2 + 0) * DM * 2 * DFF, DM, 2 * DFF, (bf16_t*)(ws + W_GU0), scr, r, lane); continue; } r -= I_GU;
        if (r < I_GU) { if (part != 1) tr_item<1>(P.in[I_WGU] + (size_t)(l * 2 + 1) * DM * 2 * DFF, DM, 2 * DFF, (bf16_t*)(ws + W_GU1), scr, r, lane); continue; } r -= I_GU;
        if (r < I_DN) { if (part != 2) tr_item<0>(P.in[I_WDN] + (size_t)(l * 2 + 0) * DFF * DM, DFF, DM, (bf16_t*)(ws + W_DN0), scr, r, lane); continue; } r -= I_DN;
        if (r < I_DN) { if (part != 1) tr_item<0>(P.in[I_WDN] + (size_t)(l * 2 + 1) * DFF * DM, DFF, DM, (bf16_t*)(ws + W_DN1), scr, r, lane); continue; } r -= I_DN;
        if (r < n_in) { if (part == 2) continue; if (l & 1) tr_item<0>(P.in[I_CIN] + (size_t)i2 * DM * CINW, DM, CINW, (bf16_t*)(ws + W_IN), scr, r, lane);
                        else tr_item<2>(P.in[I_ABIN] + (size_t)i2 * DM * 2832, DM, 2832, (bf16_t*)(ws + W_IN), scr, r, lane); continue; } r -= n_in;
        if (part != 1) tr_item<0>(((l & 1) ? P.in[I_COUT] : P.in[I_ABOUT]) + (size_t)i2 * DM * DM, DM, DM, (bf16_t*)(ws + W_OUT), scr, r, lane);
    }
    if (!(l & 1) && part != 2) {
        u32x4* z = (u32x4*)((bf16_t*)(ws + W_IN) + (size_t)2832 * DM); const int n16 = 240 * DM * 2 / 16;
        const unsigned z0 = (unsigned)opq(0); for (int i = gw * 64 + lane; i < n16; i += NGW * 64) z[i] = (u32x4){z0, z0, z0, z0};
    }
}

DI void mod_phase(const Params& P, unsigned char* lds, int tid_, int wave, int lane_) {
    const int tid = opq(threadIdx.x), lane = tid & 63;
    float* sc = (float*)lds; float* red = (float*)(lds + 36864);
    for (int idx = tid; idx < 9 * DM; idx += 512) { const int b9 = idx >> 10, k = idx & 1023; const float v = b9 < 8 ? P.in[I_C][b9 * DM + k] : P.in[I_CCTX][k]; sc[idx] = v / (1.f + __expf(-v)); }
    __syncthreads();
    float* MOD = (float*)(P.ws + WS_MOD);
    for (int item = blockIdx.x; item < 144; item += gridDim.x) {
        const int l = item / 36, cb = item % 36;
        const float* W = P.in[I_ADAW] + (size_t)l * DM * NMODW + cb * 256 + lane * 4;
        f32x4 acc[9];
#pragma unroll
        for (int b = 0; b < 9; ++b) acc[b] = (f32x4){0.f, 0.f, 0.f, 0.f};
#pragma unroll 8
        for (int kk = 0; kk < 128; ++kk) { const int k = wave * 128 + kk; const f32x4 w = *(const f32x4*)(W + (size_t)k * NMODW);
#pragma unroll
            for (int b = 0; b < 9; ++b) acc[b] += w * sc[b * DM + k]; }
#pragma unroll
        for (int b = 0; b < 9; ++b) *(f32x4*)&red[(wave * 9 + b) * 256 + lane * 4] = acc[b];
        __syncthreads();
        for (int o = tid; o < 9 * 256; o += 512) { const int b9 = o >> 8, cc = o & 255; float s = 0.f;
#pragma unroll
            for (int w = 0; w < 8; ++w) s += red[(w * 9 + b9) * 256 + cc];
            MOD[(size_t)(l * 9 + b9) * NMODW + cb * 256 + cc] = s + P.in[I_ADAB][l * NMODW + cb * 256 + cc]; }
        __syncthreads();
    }
}

DI const float* xin_row(const Params& P, int row) { const int b = row / SEGR, p = row % SEGR; return p < CTXL ? P.in[I_CTX] + (size_t)(b * CTXL + p) * DM : P.in[I_X] + (size_t)(b * SEQ + p - CTXL) * DM; }
DI void init_pass(const Params& P, int gw, int NGW, int lane_) {
    const int lane = opq(threadIdx.x) & 63;
    float* X = (float*)(P.ws + WS_X); bf16_t* H = (bf16_t*)P.out; const float* MOD = (const float*)(P.ws + WS_MOD);
    f32x4 xn[4];
#define IN_LOAD(r) do { const float* xr_ = xin_row(P, (r)) + lane * 4; _Pragma("unroll") for (int j = 0; j < 4; ++j) xn[j] = *(const f32x4*)(xr_ + j * 256); } while (0)
    if (gw < MROWS) IN_LOAD(gw);
    for (int row = gw; row < MROWS; row += NGW) {
        f32x4 x[4];
#pragma unroll
        for (int j = 0; j < 4; ++j) x[j] = xn[j];
        if (row + NGW < MROWS) IN_LOAD(row + NGW);
        const int b = row / SEGR, p = row % SEGR, b9 = p < CTXL ? 8 : b;
        const float* sh = MOD + (size_t)b9 * NMODW + lane * 4; const float* sc = sh + DM;
#pragma unroll
        for (int j = 0; j < 4; ++j) { const int col = j * 256 + lane * 4; const f32x4 s1 = *(const f32x4*)(sc + j * 256), s0 = *(const f32x4*)(sh + j * 256);
            const f32x4 h = x[j] * (s1 + 1.f) + s0;
            u32x2 w; w.x = pk2(h[0], h[1]); w.y = pk2(h[2], h[3]); *(u32x2*)(H + (size_t)row * DM + col) = w; }
    }
#undef IN_LOAD
}
DI void ln_pass(const Params& P, int l, int s, float coef, int npart, int gw, int NGW, int lane_) {
    const int lane = opq(threadIdx.x) & 63;
    float* X = (float*)(P.ws + WS_X); bf16_t* H = (bf16_t*)P.out; const bf16_t* Y = (const bf16_t*)(P.ws + WS_Y); const float* MOD = (const float*)(P.ws + WS_MOD);
    const bool first = (l == 0 && s == 0);
    const bool last = (l == 3 && s == 2), noctx = (l == 3 && s >= 1); const bool tailsplit = (NGW == 2048); const bf16_t* YPp = (const bf16_t*)(P.ws + WS_YP);
    const int nl = s < 2 ? l : l + 1, ns = s < 2 ? s + 1 : 0;
    const float* lg = P.in[I_LNG] + (l * 3 + s) * DM + lane * 4; const float* lb = P.in[I_LNB] + (l * 3 + s) * DM + lane * 4;
    const int RPW = (MROWS + NGW - 1) / NGW; const int nrows = tailsplit ? 17 : ((gw * RPW + RPW) < MROWS ? RPW : (MROWS - gw * RPW > 0 ? MROWS - gw * RPW : 0));
#define LN_ROW(k) (tailsplit ? ((k) < 16 ? gw * 16 + (k) : pg8::TAIL_ROW0 + gw) : gw * RPW + (k))
    f32x4 pg[4], plg[4], plb[4], psc[4], psh[4];
#pragma unroll
    for (int j = 0; j < 4; ++j) { plg[j] = *(const f32x4*)(lg + j * 256); plb[j] = *(const f32x4*)(lb + j * 256); }
    int cur_b9 = -1;
    f32x4 xn[4]; u32x2 yn[4];
    if (tailsplit && npart > 0 && !(noctx && ((pg8::TAIL_ROW0 + gw) % SEGR) < CTXL)) {
        bf16_t* yr = (bf16_t*)(P.ws + WS_Y) + (size_t)(pg8::TAIL_ROW0 + gw) * DM + lane * 4;
        f32x4 ys[4];
#pragma unroll
        for (int j = 0; j < 4; ++j) { const u32x2 e = *(const u32x2*)(yr + j * 256); ys[j] = (f32x4){bflo(e.x), bfhi(e.x), bflo(e.y), bfhi(e.y)}; }
#pragma unroll
        for (int pp = 0; pp < 7; ++pp) if (pp < npart) {
#pragma unroll
            for (int j = 0; j < 4; ++j) { const u32x2 e = *(const u32x2*)(YPp + ((size_t)pp * 2048 + gw) * DM + j * 256 + lane * 4); ys[j] += (f32x4){bflo(e.x), bfhi(e.x), bflo(e.y), bfhi(e.y)}; } }
#pragma unroll
        for (int j = 0; j < 4; ++j) { u32x2 w; w.x = pk2(ys[j][0], ys[j][1]); w.y = pk2(ys[j][2], ys[j][3]); *(u32x2*)(yr + j * 256) = w; }
    }
#define LN_LOAD(r) do { const float* xs_ = first ? xin_row(P, (r)) : X + (size_t)(r) * DM; _Pragma("unroll") for (int j = 0; j < 4; ++j) { xn[j] = *(const f32x4*)(xs_ + j * 256 + lane * 4); yn[j] = *(const u32x2*)(Y + (size_t)(r) * DM + j * 256 + lane * 4); } } while (0)
    if (nrows > 0) LN_LOAD(LN_ROW(0));
    for (int k = 0; k < nrows; ++k) {
        const int row = LN_ROW(k);
        f32x4 x[4]; u32x2 yw[4];
#pragma unroll
        for (int j = 0; j < 4; ++j) { x[j] = xn[j]; yw[j] = yn[j]; }
        if (k + 1 < nrows) { const int rn = LN_ROW(k + 1); LN_LOAD(rn); }
        const int b = row / SEGR, p = row % SEGR, b9 = p < CTXL ? 8 : b;
        if (noctx && p < CTXL) continue;
        if (b9 != cur_b9) { cur_b9 = b9;
            const float* gate = MOD + (size_t)(l * 9 + b9) * NMODW + (3 * s + 2) * DM + lane * 4;
            const float* sh = MOD + (size_t)((nl & 3) * 9 + b9) * NMODW + (3 * ns) * DM + lane * 4;
#pragma unroll
            for (int j = 0; j < 4; ++j) { pg[j] = *(const f32x4*)(gate + j * 256) * coef; psh[j] = *(const f32x4*)(sh + j * 256); psc[j] = *(const f32x4*)(sh + DM + j * 256) + 1.f; } }
        f32x4 v[4]; float sum = 0.f;
#pragma unroll
        for (int j = 0; j < 4; ++j) { const f32x4 y = (f32x4){bflo(yw[j].x), bfhi(yw[j].x), bflo(yw[j].y), bfhi(yw[j].y)};
            v[j] = x[j] * ALPHA + pg[j] * y; sum += (v[j][0] + v[j][1]) + (v[j][2] + v[j][3]); }
        const float mean = wave_sum(sum) * (1.f / DM); float s2 = 0.f;
#pragma unroll
        for (int j = 0; j < 4; ++j) { v[j] = v[j] - mean; s2 += (v[j][0] * v[j][0] + v[j][1] * v[j][1]) + (v[j][2] * v[j][2] + v[j][3] * v[j][3]); }
        const float rstd = 1.f / sqrtf(wave_sum(s2) * (1.f / DM) + LN_EPS);
#pragma unroll
        for (int j = 0; j < 4; ++j) { const int col = j * 256 + lane * 4; const f32x4 o = v[j] * rstd * plg[j] + plb[j];
            if (last) { *(f32x4*)(P.out + (size_t)(b * SEQ + p - CTXL) * DM + col) = o; }
            else { *(f32x4*)(X + (size_t)row * DM + col) = o; const f32x4 h = o * psc[j] + psh[j];
                u32x2 w; w.x = pk2(h[0], h[1]); w.y = pk2(h[2], h[3]); *(u32x2*)(H + (size_t)row * DM + col) = w; } }
    }
#undef LN_LOAD
#undef LN_ROW
}


DI void rope_cs(float (&cs)[8], float (&sn)[8], int f0, int nfreq, float pos_r, float pos_c) {
    const float l2t = 13.287712379549449f / (float)nfreq;
#pragma unroll
    for (int e = 0; e < 8; ++e) { const int f = f0 + e; const int fi = f % nfreq; const float inv = __builtin_amdgcn_exp2f(-(float)fi * l2t);
        float rev = (f < nfreq ? pos_r : pos_c) * inv * 0.15915494309189535f; rev -= rintf(rev);
        cs[e] = __builtin_amdgcn_cosf(rev); sn[e] = __builtin_amdgcn_sinf(rev); }
}
DI void cprep_pass(const Params& P, int i2, int gw, int NGW, int lane_) {
    const int lane = opq(threadIdx.x) & 63;
    bf16_t* QKV = (bf16_t*)(P.ws + WS_QKV);
    const int cj = lane & 15;
    const float qscale = 0.08838834764831845f * LOG2E;
    const int RPW = (MROWS + NGW - 1) / NGW; const int r0 = gw * RPW, r1 = (r0 + RPW) < MROWS ? (r0 + RPW) : MROWS;
    f32x4 nwq[2], nwk[2];
    nwq[0] = *(const f32x4*)(P.in[I_CQN] + i2 * 128 + cj * 8); nwq[1] = *(const f32x4*)(P.in[I_CQN] + i2 * 128 + cj * 8 + 4);
    nwk[0] = *(const f32x4*)(P.in[I_CKN] + i2 * 128 + cj * 8); nwk[1] = *(const f32x4*)(P.in[I_CKN] + i2 * 128 + cj * 8 + 4);
    u32x4 nx[3];
#define CP_LOAD(r) do { _Pragma("unroll") for (int i = 2; i < 3; ++i) nx[i] = (lane + 64 * i < 160) ? *(const u32x4*)(QKV + (size_t)(r) * CINW + (lane + 64 * i) * 8) : (u32x4){0u, 0u, 0u, 0u}; } while (0)
    if (r0 < r1) CP_LOAD(r0);
    for (int row = r0; row < r1; ++row) {
        u32x4 cx[3];
        cx[2] = nx[2];
        if (row + 1 < r1) CP_LOAD(row + 1);
        const int p = row % SEGR; const bool lat = p >= CTXL; const int t = p - CTXL;
        float cs[8], sn[8];
        if (lat) rope_cs(cs, sn, 8 * (cj & 7), 32, (float)(t >> 6), (float)(t & 63));
#pragma unroll
        for (int i = 2; i < 3; ++i) {
            const int ci = lane + 64 * i; const bool ok = ci < 160; const int head = ci >> 4;
            bf16_t* ptr = QKV + (size_t)row * CINW + ci * 8;
            const u32x4 w = cx[i];
            float x[8] = {bflo(w.x), bfhi(w.x), bflo(w.y), bfhi(w.y), bflo(w.z), bfhi(w.z), bflo(w.w), bfhi(w.w)};
            float ss = 0.f;
#pragma unroll
            for (int e = 0; e < 8; ++e) ss += x[e] * x[e];
            ss += __shfl_xor(ss, 1); ss += __shfl_xor(ss, 2); ss += __shfl_xor(ss, 4); ss += __shfl_xor(ss, 8);
            const float rinv = 1.f / sqrtf(ss * (1.f / 128.f) + LN_EPS);
            const f32x4 n0 = head < 8 ? nwq[0] : nwk[0], n1 = head < 8 ? nwq[1] : nwk[1];
#pragma unroll
            for (int e = 0; e < 4; ++e) { x[e] = x[e] * rinv * n0[e]; x[e + 4] = x[e + 4] * rinv * n1[e]; }
            float y[8];
#pragma unroll
            for (int e = 0; e < 8; ++e) { const float o = __shfl_xor(x[e], 8);
                y[e] = !lat ? x[e] : (cj < 8 ? x[e] * cs[e] - o * sn[e] : o * sn[e] + x[e] * cs[e]); }
            const float sc = head < 8 ? qscale : 1.f;
            if (ok) { u32x4 o; o.x = pk2(y[0] * sc, y[1] * sc); o.y = pk2(y[2] * sc, y[3] * sc); o.z = pk2(y[4] * sc, y[5] * sc); o.w = pk2(y[6] * sc, y[7] * sc); *(u32x4*)ptr = o; }
        }
    }
#undef CP_LOAD
}

template <int D>
DI void attn_unit(LAS unsigned char* lds, const bf16_t* Qp, bf16_t* Op, int ldq, const bf16_t* Kp, const bf16_t* Vp, int ldk,
                  int nt0, int p1, int nt1, bool win, int pq0, bool has_sink, float sink_l2, int tq0, int tid, int wave, int lane) {
    constexpr int PITCH = (D + 8) * 2, VPITCH = (D + 16) * 2, NCH = D / 64, DB = D / 32, DK = D / 16, CPR = D / 8;
    LAS unsigned char* Ks = lds; LAS unsigned char* Vs = lds + 64 * PITCH;
    const int qi = lane & 31, hi = lane >> 5, q4 = (lane & 15) >> 2, p4 = lane & 3, blk = (lane >> 4) & 1;
    bf16x8 qr[DK];
    { const bf16_t* qrow = Qp + (size_t)(32 * wave + qi) * ldq + 8 * hi;
#pragma unroll
      for (int dd = 0; dd < DK; ++dd) qr[dd] = *(const bf16x8*)(qrow + 16 * dd); }
    if (D == 64) {
        float qf[4][8];
#pragma unroll
        for (int dd = 0; dd < 4; ++dd)
#pragma unroll
            for (int e = 0; e < 8; ++e) qf[dd][e] = bf2f(qr[dd & (DK - 1)][e]);
        if (tq0 >= 0) { const int t = tq0 + 32 * wave + qi; const float pr = (float)(t >> 6), pc = (float)(t & 63);
#pragma unroll
            for (int dd = 0; dd < 2; ++dd) { float cs[8], sn[8]; rope_cs(cs, sn, 16 * dd + 8 * hi, 16, pr, pc);
#pragma unroll
                for (int e = 0; e < 8; ++e) { const float x1 = qf[dd][e], x2 = qf[dd + 2][e]; qf[dd][e] = x1 * cs[e] - x2 * sn[e]; qf[dd + 2][e] = x1 * sn[e] + x2 * cs[e]; } } }
        const float qs = 0.125f * LOG2E;
#pragma unroll
        for (int dd = 0; dd < 4; ++dd) { u32x4 w; w.x = pk2(qf[dd][0] * qs, qf[dd][1] * qs); w.y = pk2(qf[dd][2] * qs, qf[dd][3] * qs); w.z = pk2(qf[dd][4] * qs, qf[dd][5] * qs); w.w = pk2(qf[dd][6] * qs, qf[dd][7] * qs); qr[dd & (DK - 1)] = __builtin_bit_cast(bf16x8, w); }
    }
    f32x16 o[DB];
#pragma unroll
    for (int db = 0; db < DB; ++db)
#pragma unroll
        for (int r = 0; r < 16; ++r) o[db][r] = 0.f;
    float m = -1e30f, l = 0.f;
    const int NT = nt0 + nt1;
    u32x4 kreg[NCH], vreg[NCH];
#define ATT_LOADT(t) do { const int pt_ = (t) < nt0 ? 64 * (t) : p1 + 64 * ((t) - nt0); _Pragma("unroll") for (int i_ = 0; i_ < NCH; ++i_) { const int cid = tid + 512 * i_, row = cid / CPR, cc = cid % CPR; \
        kreg[i_] = *(const u32x4*)(Kp + (size_t)(pt_ + row) * ldk + cc * 8); vreg[i_] = *(const u32x4*)(Vp + (size_t)(pt_ + row) * ldk + cc * 8); } } while (0)
    ATT_LOADT(0);
    for (int t = 0; t < NT; ++t) {
        __syncthreads();
#pragma unroll
        for (int i = 0; i < NCH; ++i) { const int cid = tid + 512 * i, row = cid / CPR, cc = cid % CPR; *(LAS u32x4*)(Ks + row * PITCH + cc * 16) = kreg[i]; *(LAS u32x4*)(Vs + row * VPITCH + cc * 16) = vreg[i]; }
        __syncthreads();
        if (t + 1 < NT) ATT_LOADT(t + 1);
        f32x16 s0, s1;
#pragma unroll
        for (int r = 0; r < 16; ++r) { s0[r] = 0.f; s1[r] = 0.f; }
#pragma unroll
        for (int dd = 0; dd < DK; ++dd) { const bf16x8 a0 = *(const LAS bf16x8*)(Ks + qi * PITCH + (16 * dd + 8 * hi) * 2), a1 = *(const LAS bf16x8*)(Ks + (32 + qi) * PITCH + (16 * dd + 8 * hi) * 2);
            s0 = MFMA32(a0, qr[dd], s0); s1 = MFMA32(a1, qr[dd], s1); }
        if (win && t >= nt0) { const int pt = p1 + 64 * (t - nt0), pq = pq0 + 32 * wave + qi;
#pragma unroll
            for (int r = 0; r < 16; ++r) { const int dk = pq - (pt + crow(r, hi)); if (dk > 128 || dk < -128) s0[r] = -1e30f; if (dk - 32 > 128 || dk - 32 < -128) s1[r] = -1e30f; } }
        float mx = fmaxf(s0[0], s1[0]);
#pragma unroll
        for (int r = 1; r < 16; ++r) mx = fmaxf(mx, fmaxf(s0[r], s1[r]));
        mx = fmaxf(mx, __shfl_xor(mx, 32));
        const float mnew = fmaxf(m, mx), f = __builtin_amdgcn_exp2f(m - mnew); m = mnew;
        float ps = 0.f;
#pragma unroll
        for (int r = 0; r < 16; ++r) { s0[r] = __builtin_amdgcn_exp2f(s0[r] - m); s1[r] = __builtin_amdgcn_exp2f(s1[r] - m); ps += s0[r] + s1[r]; }
        l = l * f + ps;
#pragma unroll
        for (int db = 0; db < DB; ++db)
#pragma unroll
            for (int r = 0; r < 16; ++r) o[db][r] *= f;
        bf16x8 pw[4]; pw[0] = pack8(s0, 0); pw[1] = pack8(s0, 1); pw[2] = pack8(s1, 0); pw[3] = pack8(s1, 1);
#pragma unroll
        for (int db = 0; db < DB; ++db)
#pragma unroll
            for (int s4 = 0; s4 < 4; ++s4) { const LAS unsigned char* vp = Vs + (16 * s4 + 4 * hi + q4) * VPITCH + (32 * db + 16 * blk) * 2 + 8 * p4;
                const bf16x8 a = cat8(trrd(vp), trrd(vp + 8 * VPITCH)); o[db] = MFMA32(a, pw[s4], o[db]); }
    }
#undef ATT_LOADT
    float lt = l + __shfl_xor(l, 32); if (has_sink) lt += __builtin_amdgcn_exp2f(sink_l2 - m);
    const float inv = 1.f / lt;
    bf16_t* orow = Op + (size_t)(32 * wave + qi) * ldq + 4 * hi;
#pragma unroll
    for (int db = 0; db < DB; ++db)
#pragma unroll
        for (int g = 0; g < 4; ++g) { u32x2 w; w.x = pk2(o[db][4 * g] * inv, o[db][4 * g + 1] * inv); w.y = pk2(o[db][4 * g + 2] * inv, o[db][4 * g + 3] * inv); *(u32x2*)(orow + 32 * db + 8 * g) = w; }
}

namespace xat {
constexpr int D = 128, NW = 8, QBLK = 32, KVBLK = 64, LDQ = CINW, LDK = CINW, LDO = CINW;
constexpr float THRL = 11.5f;
constexpr size_t SHM_V = KVBLK * D * 2, SHM_K = KVBLK * D * 2, SHM_ATTN = 2 * SHM_V + 2 * SHM_K + NW * 64 * 4;
#define KSWZ(row, colB) ((row) * 256 + ((colB) ^ (((row) & 7) << 4)))
#define SBAR() __builtin_amdgcn_sched_barrier(0)
DI unsigned cvtpk(float lo, float hi) { unsigned r; asm volatile("v_cvt_pk_bf16_f32 %0, %1, %2" : "=v"(r) : "v"(lo), "v"(hi)); return r; }
DI void partialSM(f32x16& p0, f32x16& p1, float& m_reg, float& mn, float& alpha) {
  float pmax = p0[0];
#pragma unroll
  for (int r = 1; r < 16; ++r) pmax = fmaxf(pmax, p0[r]);
#pragma unroll
  for (int r = 0; r < 16; ++r) pmax = fmaxf(pmax, p1[r]);
  { auto rr = __builtin_amdgcn_permlane32_swap(__float_as_uint(pmax), __float_as_uint(pmax), false, false);
    pmax = fmaxf(__uint_as_float(rr[0]), __uint_as_float(rr[1])); }
  if (__builtin_expect(__all(pmax - m_reg <= THRL), 1)) { mn = m_reg; alpha = 1.f; }
  else { mn = fmaxf(m_reg, pmax); alpha = __builtin_amdgcn_exp2f(m_reg - mn); m_reg = mn; }
#pragma unroll
  for (int r = 0; r < 16; ++r) p0[r] = p0[r] - mn;
#pragma unroll
  for (int r = 0; r < 16; ++r) p1[r] = p1[r] - mn;
#pragma unroll
  for (int r = 0; r < 16; ++r) p0[r] = __builtin_amdgcn_exp2f(p0[r]);
}
DI void finishSM(f32x16& p0, f32x16& p1, float alpha, float& l_reg, bf16x8& pa0, bf16x8& pa1, bf16x8& pa2, bf16x8& pa3) {
#pragma unroll
  for (int r = 0; r < 16; ++r) p1[r] = __builtin_amdgcn_exp2f(p1[r]);
  float ps = 0;
#pragma unroll
  for (int r = 0; r < 16; ++r) ps += p0[r];
#pragma unroll
  for (int r = 0; r < 16; ++r) ps += p1[r];
  { auto rr = __builtin_amdgcn_permlane32_swap(__float_as_uint(ps), __float_as_uint(ps), false, false);
    ps = __uint_as_float(rr[0]) + __uint_as_float(rr[1]); }
  l_reg = l_reg * alpha + ps;
#define PK4(P, BASE, OUT) do { unsigned a0 = cvtpk(P[BASE + 0], P[BASE + 1]), a1 = cvtpk(P[BASE + 2], P[BASE + 3]);   \
    unsigned b0 = cvtpk(P[BASE + 4], P[BASE + 5]), b1 = cvtpk(P[BASE + 6], P[BASE + 7]);                              \
    auto r0 = __builtin_amdgcn_permlane32_swap(a0, b0, false, false); auto r1 = __builtin_amdgcn_permlane32_swap(a1, b1, false, false); \
    u32x4 w = {r0[0], r1[0], r0[1], r1[1]}; OUT = __builtin_bit_cast(bf16x8, w); } while (0)
  PK4(p0, 0, pa0); PK4(p0, 8, pa1); PK4(p1, 0, pa2); PK4(p1, 8, pa3);
#undef PK4
}
DI void qkt(f32x16& p0, f32x16& p1, const char* Ks, const bf16x8* qr, int r32, int hi) {
#pragma unroll
  for (int r = 0; r < 16; ++r) { p0[r] = 0.f; p1[r] = 0.f; }
#pragma unroll
  for (int d0 = 0; d0 < 8; ++d0) { const int cb = (d0 * 16 + hi * 8) * 2;
    const bf16x8 b0 = *reinterpret_cast<const bf16x8*>(Ks + KSWZ(r32, cb));
    const bf16x8 b1 = *reinterpret_cast<const bf16x8*>(Ks + KSWZ(32 + r32, cb));
    p0 = MFMA32(b0, qr[d0], p0); p1 = MFMA32(b1, qr[d0], p1); }
}
DI int v_st(int k, int c) { const int kk = (k & ~0xC) | ((k & 4) << 1) | ((k & 8) >> 1); return ((kk >> 3) * 4 + (c >> 5)) * 512 + ((kk & 7) * 32 + (c & 31)) * 2; }
DI int v_rd_base(int lane) { return ((lane & 3) << 3) | (((lane >> 2) & 3) << 6) | (((lane >> 4) & 1) << 5) | (((lane >> 5) & 1) << 8); }
constexpr int v_rd_off(int d0, int ks, int half) { return d0 * 512 + ks * 4096 + half * 2048; }
template <int OFF> DI s16x4 tr_read(int vb) { s16x4 r; asm volatile("ds_read_b64_tr_b16 %0, %1 offset:%2" : "=&v"(r) : "v"(vb), "i"(OFF) : "memory"); return r; }
template <int D0> DI void pv_one(f32x16& od, int vb, bf16x8 pa0, bf16x8 pa1, bf16x8 pa2, bf16x8 pa3) {
  const s16x4 l0 = tr_read<v_rd_off(D0, 0, 0)>(vb), h0 = tr_read<v_rd_off(D0, 0, 1)>(vb), l1 = tr_read<v_rd_off(D0, 1, 0)>(vb), h1 = tr_read<v_rd_off(D0, 1, 1)>(vb);
  const s16x4 l2 = tr_read<v_rd_off(D0, 2, 0)>(vb), h2 = tr_read<v_rd_off(D0, 2, 1)>(vb), l3 = tr_read<v_rd_off(D0, 3, 0)>(vb), h3 = tr_read<v_rd_off(D0, 3, 1)>(vb);
  asm volatile("s_waitcnt lgkmcnt(0)" ::: "memory"); SBAR();
  od = MFMA32(pa0, cat8(l0, h0), od); od = MFMA32(pa1, cat8(l1, h1), od); od = MFMA32(pa2, cat8(l2, h2), od); od = MFMA32(pa3, cat8(l3, h3), od);
}
DI void pv_d0(f32x16* o, int vb, bf16x8 pa0, bf16x8 pa1, bf16x8 pa2, bf16x8 pa3) {
  pv_one<0>(o[0], vb, pa0, pa1, pa2, pa3); pv_one<1>(o[1], vb, pa0, pa1, pa2, pa3); pv_one<2>(o[2], vb, pa0, pa1, pa2, pa3); pv_one<3>(o[3], vb, pa0, pa1, pa2, pa3);
}
DI void attn_dense_body(const bf16_t* Qb, const bf16_t* __restrict__ Kh, const bf16_t* __restrict__ Vh, bf16_t* Ob, int seq, char* lds, const float* qnw, int t0) {
  const int tid = opq(threadIdx.x), wid = tid >> 6, lane = tid & 63, r32 = lane & 31, hi = lane >> 5;
  char* V_lds = lds; char* K_lds = lds + 2 * SHM_V;
  float* ws = (float*)(lds + 2 * SHM_V + 2 * SHM_K) + wid * 64; float* li_l = ws; float* al_l = ws + 32;
  float m_reg = -1e30f, l_reg = 0; f32x16 o[4]; bf16x8 qr[8];
#pragma unroll
  for (int d = 0; d < 4; ++d)
#pragma unroll
    for (int r = 0; r < 16; ++r) o[d][r] = 0.f;
  const bf16_t* Qw = Qb + (long)(wid * QBLK + r32) * LDQ + hi * 8;
#pragma unroll
  for (int d0 = 0; d0 < 8; ++d0) qr[d0] = *reinterpret_cast<const bf16x8*>(Qw + d0 * 16);
  {
    float qf[8][8]; float ss = 0.f;
#pragma unroll
    for (int d0 = 0; d0 < 8; ++d0)
#pragma unroll
      for (int e = 0; e < 8; ++e) { qf[d0][e] = bf2f(qr[d0][e]); ss += qf[d0][e] * qf[d0][e]; }
    { auto rr = __builtin_amdgcn_permlane32_swap(__float_as_uint(ss), __float_as_uint(ss), false, false); ss = __uint_as_float(rr[0]) + __uint_as_float(rr[1]); }
    const float rinv = 1.f / sqrtf(ss * (1.f / 128.f) + LN_EPS);
#pragma unroll
    for (int d0 = 0; d0 < 8; ++d0) { const f32x4 w0 = *(const f32x4*)(qnw + 16 * d0 + 8 * hi), w1 = *(const f32x4*)(qnw + 16 * d0 + 8 * hi + 4);
#pragma unroll
      for (int e = 0; e < 4; ++e) { qf[d0][e] *= rinv * w0[e]; qf[d0][e + 4] *= rinv * w1[e]; } }
    if (t0 >= 0) { const int t = t0 + wid * QBLK + r32; const float pr = (float)(t >> 6), pc = (float)(t & 63);
#pragma unroll
      for (int d0 = 0; d0 < 4; ++d0) { float cs[8], sn[8]; rope_cs(cs, sn, 16 * d0 + 8 * hi, 32, pr, pc);
#pragma unroll
        for (int e = 0; e < 8; ++e) { const float x1 = qf[d0][e], x2 = qf[d0 + 4][e]; qf[d0][e] = x1 * cs[e] - x2 * sn[e]; qf[d0 + 4][e] = x1 * sn[e] + x2 * cs[e]; } } }
    const float qs = 0.08838834764831845f * LOG2E;
#pragma unroll
    for (int d0 = 0; d0 < 8; ++d0) { u32x4 w; w.x = pk2(qf[d0][0] * qs, qf[d0][1] * qs); w.y = pk2(qf[d0][2] * qs, qf[d0][3] * qs); w.z = pk2(qf[d0][4] * qs, qf[d0][5] * qs); w.w = pk2(qf[d0][6] * qs, qf[d0][7] * qs); qr[d0] = __builtin_bit_cast(bf16x8, w); }
  }
  const int sr = tid >> 4, sc = (tid & 15) * 8, vst0 = v_st(sr, sc), vst1 = v_st(32 + sr, sc);
  const int vb0 = (int)(uintptr_t)V_lds + v_rd_base(lane);
  struct { bf16x8 vs0, vs1, ks0, ks1; } sr_[2];
#define SLOAD(i, k0) do { sr_[i].vs0 = *reinterpret_cast<const bf16x8*>(&Vh[(long)((k0) + sr) * LDK + sc]); sr_[i].vs1 = *reinterpret_cast<const bf16x8*>(&Vh[(long)((k0) + 32 + sr) * LDK + sc]); \
    sr_[i].ks0 = *reinterpret_cast<const bf16x8*>(&Kh[(long)((k0) + sr) * LDK + sc]); sr_[i].ks1 = *reinterpret_cast<const bf16x8*>(&Kh[(long)((k0) + 32 + sr) * LDK + sc]); } while (0)
#define SWRITE(b, i) do { *(bf16x8*)(V_lds + (b) * SHM_V + vst0) = sr_[i].vs0; *(bf16x8*)(V_lds + (b) * SHM_V + vst1) = sr_[i].vs1; const int kc = sc * 2; \
    *(bf16x8*)(K_lds + (b) * SHM_K + KSWZ(sr, kc)) = sr_[i].ks0; *(bf16x8*)(K_lds + (b) * SHM_K + KSWZ(32 + sr, kc)) = sr_[i].ks1; } while (0)
#define SWAIT() asm volatile("s_waitcnt vmcnt(4)" ::: "memory")
#define RESC(a) do { if (__any((a) < 1.f)) { if (hi == 0) al_l[r32] = (a); asm volatile("s_waitcnt lgkmcnt(0)" ::: "memory"); \
    _Pragma("unroll") for (int d = 0; d < 4; ++d) _Pragma("unroll") for (int r = 0; r < 16; ++r) o[d][r] *= al_l[crow(r, hi)]; } } while (0)
  f32x16 pA0, pA1, pB0, pB1; float mnA, mnB, alA, alB; bf16x8 pa0, pa1, pa2, pa3; const int NT = seq / KVBLK;
  constexpr int SE = 0, SO = 1;
  SLOAD(SE, 0); asm volatile("s_waitcnt vmcnt(0)" ::: "memory"); SWRITE(0, SE); __syncthreads();
  qkt(pA0, pA1, K_lds, qr, r32, hi); partialSM(pA0, pA1, m_reg, mnA, alA);
  SLOAD(SO, KVBLK); if (2 < NT) SLOAD(SE, 2 * KVBLK);
  SWAIT(); SWRITE(1, SO); __syncthreads();
  for (int j = 1; j + 1 < NT; j += 2) {
    SBAR(); qkt(pB0, pB1, K_lds + SHM_K, qr, r32, hi);
    finishSM(pA0, pA1, alA, l_reg, pa0, pa1, pa2, pa3); SBAR();
    SLOAD(SO, (j + 2) * KVBLK); SBAR();
    pv_d0(o, vb0, pa0, pa1, pa2, pa3); partialSM(pB0, pB1, m_reg, mnB, alB);
    __syncthreads(); SWAIT(); SWRITE(0, SE);
    RESC(alB); __syncthreads();
    SBAR(); qkt(pA0, pA1, K_lds, qr, r32, hi);
    finishSM(pB0, pB1, alB, l_reg, pa0, pa1, pa2, pa3); SBAR();
    if (j + 3 < NT) SLOAD(SE, (j + 3) * KVBLK); SBAR();
    pv_d0(o, vb0 + (int)SHM_V, pa0, pa1, pa2, pa3); partialSM(pA0, pA1, m_reg, mnA, alA);
    __syncthreads(); SWAIT(); SWRITE(1, SO);
    RESC(alA); __syncthreads();
  }
  SBAR(); qkt(pB0, pB1, K_lds + SHM_K, qr, r32, hi);
  finishSM(pA0, pA1, alA, l_reg, pa0, pa1, pa2, pa3); SBAR();
  pv_d0(o, vb0, pa0, pa1, pa2, pa3); partialSM(pB0, pB1, m_reg, mnB, alB);
  __syncthreads(); RESC(alB);
  finishSM(pB0, pB1, alB, l_reg, pa0, pa1, pa2, pa3); SBAR();
  pv_d0(o, vb0 + (int)SHM_V, pa0, pa1, pa2, pa3);
  if (hi == 0) li_l[r32] = l_reg; asm volatile("s_waitcnt lgkmcnt(0)" ::: "memory");
  float rli[16];
#pragma unroll
  for (int r = 0; r < 16; ++r) rli[r] = __builtin_amdgcn_rcpf(li_l[crow(r, hi)]);
  bf16_t* Ow = Ob + (long)(wid * QBLK) * LDO;
#pragma unroll
  for (int r = 0; r < 16; ++r) { const int orow = crow(r, hi);
#pragma unroll
    for (int d0 = 0; d0 < 4; ++d0) Ow[(long)orow * LDO + d0 * 32 + r32] = (bf16_t)(cvtpk(o[d0][r] * rli[r], 0.f) & 0xffffu); }
  asm volatile("s_waitcnt vmcnt(0) lgkmcnt(0)" ::: "memory");
  __syncthreads();
#undef SLOAD
#undef SWRITE
#undef SWAIT
#undef RESC
}
#undef KSWZ
#undef SBAR
}

DI void attn_c_phase(const Params& P, char* glds, bool ctx_out, int i2, int tid_, int wave, int lane_) {
    const int tid = opq(threadIdx.x), lane = tid & 63;
    bf16_t* QKV = (bf16_t*)(P.ws + WS_QKV);
    const int nunits = 1024 + (ctx_out ? 64 : 0);
    const int G_ = gridDim.x; const int vcu = (G_ % 8 == 0) ? ((int)blockIdx.x % 8) * (G_ / 8) + (int)blockIdx.x / 8 : (int)blockIdx.x;
    for (int u = vcu; u < nunits; u += G_) {
        int b, h, qb;
        if (u < 1024) { qb = 1 + (u & 15); h = (u >> 4) & 7; b = u >> 7; } else { const int v = u - 1024; qb = 0; h = v & 7; b = v >> 3; }
        bf16_t* base = QKV + (size_t)b * SEGR * CINW;
        bf16_t* q = base + (size_t)(256 * qb) * CINW + h * 128;
        xat::attn_dense_body(q, base + 1024 + (h >> 2) * 128, base + 1280 + (h >> 2) * 128, q, qb ? 4352 : 256, glds, P.in[I_CQN] + i2 * 128, qb ? 256 * (qb - 1) : -1);
    }
}


DI void abprep_pass(const Params& P, int i2, LAS unsigned char* lds, int gw, int NGW, int lane_) {
    const int tid = opq(threadIdx.x), lane = tid & 63;
    bf16_t* QKV = (bf16_t*)(P.ws + WS_QKV); bf16_t* BQ = (bf16_t*)(P.ws + WS_BQKV); float* GT = (float*)(P.ws + WS_GATES);
    const int cj = lane & 7;
    LAS float* cwl = (LAS float*)lds;
    { const float* cw = P.in[I_ABCONV] + (size_t)i2 * 5 * 1536;
      for (int i = tid; i < 5 * 1536 / 4; i += 512) *(LAS f32x4*)(cwl + 4 * i) = *(const f32x4*)(cw + 4 * i); }
    __syncthreads();
    const int RPW = (MROWS + NGW - 1) / NGW; const int r0 = gw * RPW, r1 = (r0 + RPW) < MROWS ? (r0 + RPW) : MROWS;
    u32x4 nk; unsigned short ng = 0;
#define AB_LOADA(r) do { nk = *(const u32x4*)(QKV + (size_t)(r) * ABP + 1024 + (lane & 15) * 8); ng = QKV[(size_t)(r) * ABP + 2816 + (lane & 15)]; } while (0)
#define AB_LOADB(r, ci_) (*(const u32x4*)(QKV + (size_t)((r) < 0 ? 0 : ((r) >= MROWS ? MROWS - 1 : (r))) * ABP + 1280 + (ci_) * 8))
    const int hd = lane & 3, kind = (lane >> 2) & 3;
    const float dtb = P.in[I_DTB][i2 * 8 + (kind & 1) * 4 + hd], aexp = -__expf(P.in[I_ALOG][i2 * 8 + (kind & 1) * 4 + hd]);
    u32x4 w[3][8];
#pragma unroll
    for (int i = 0; i < 3; ++i)
#pragma unroll
        for (int k = 0; k < 7; ++k) w[i][k] = AB_LOADB(r0 - 2 + k, lane + 64 * i);
    if (r0 < r1) AB_LOADA(r0);
    for (int row = r0; row < r1; ++row) {
        const u32x4 wk = nk; const unsigned short wg = ng;
        if (row + 1 < r1) AB_LOADA(row + 1);
#pragma unroll
        for (int i = 0; i < 3; ++i) w[i][7] = AB_LOADB(row + 5, lane + 64 * i);
        const int p = row % SEGR; const bool lat = p >= CTXL; const int t = p - CTXL;
        { float cs[8], sn[8];
          if (lat) rope_cs(cs, sn, 8 * (cj & 3), 16, (float)(t >> 6), (float)(t & 63));
          float x[8] = {bflo(wk.x), bfhi(wk.x), bflo(wk.y), bfhi(wk.y), bflo(wk.z), bfhi(wk.z), bflo(wk.w), bfhi(wk.w)};
          float y[8];
#pragma unroll
          for (int e = 0; e < 8; ++e) { const float o = __shfl_xor(x[e], 4); y[e] = !lat ? x[e] : (cj < 4 ? x[e] * cs[e] - o * sn[e] : o * sn[e] + x[e] * cs[e]); }
          if (lane < 16) { u32x4 o; o.x = pk2(y[0], y[1]); o.y = pk2(y[2], y[3]); o.z = pk2(y[4], y[5]); o.w = pk2(y[6], y[7]); *(u32x4*)(QKV + (size_t)row * ABP + 1024 + lane * 8) = o;
              const float v = bf2f((short)wg); float r;
              if (kind < 2) r = 1.f / (1.f + __expf(-v));
              else { const float xx = v + dtb; const float ee = __expf(xx); const float sp = xx > 20.f ? xx : (ee < 0.01f ? ee * (1.f - ee * (0.5f - ee * 0.33333333f)) : __logf(1.f + ee)); r = aexp * sp; }
              GT[(size_t)row * 16 + lane] = r; } }
        const int plo = lat ? CTXL : 0, phi = lat ? SEGR : CTXL;
#pragma unroll
        for (int i = 0; i < 3; ++i) {
            const int ci = lane + 64 * i;
            float acc[8];
#pragma unroll
            for (int e = 0; e < 8; ++e) acc[e] = 0.f;
#pragma unroll
            for (int j = 0; j < 5; ++j) { const int pp = p + j - 2;
                if (pp >= plo && pp < phi) { const u32x4 ww = w[i][j]; const f32x4 c0 = *(const LAS f32x4*)(cwl + j * 1536 + ci * 8), c1 = *(const LAS f32x4*)(cwl + j * 1536 + ci * 8 + 4);
                    acc[0] += bflo(ww.x) * c0[0]; acc[1] += bfhi(ww.x) * c0[1]; acc[2] += bflo(ww.y) * c0[2]; acc[3] += bfhi(ww.y) * c0[3];
                    acc[4] += bflo(ww.z) * c1[0]; acc[5] += bfhi(ww.z) * c1[1]; acc[6] += bflo(ww.w) * c1[2]; acc[7] += bfhi(ww.w) * c1[3]; } }
            float ss = 0.f;
#pragma unroll
            for (int e = 0; e < 8; ++e) { acc[e] = siluf(acc[e]); ss += acc[e] * acc[e]; }
            ss += __shfl_xor(ss, 1); ss += __shfl_xor(ss, 2); ss += __shfl_xor(ss, 4); ss += __shfl_xor(ss, 8);
            const float sc = i == 2 ? 1.f : (1.f / sqrtf(ss + LN_EPS)) * (i == 0 ? 0.08838834764831845f : 1.f);
            u32x4 o; o.x = pk2(acc[0] * sc, acc[1] * sc); o.y = pk2(acc[2] * sc, acc[3] * sc); o.z = pk2(acc[4] * sc, acc[5] * sc); o.w = pk2(acc[6] * sc, acc[7] * sc);
            *(u32x4*)(BQ + (size_t)row * 1536 + ci * 8) = o;
#pragma unroll
            for (int k = 0; k < 7; ++k) w[i][k] = w[i][k + 1];
        }
    }
#undef AB_LOADA
#undef AB_LOADB
    __syncthreads();
}

constexpr int LSP = 68;
DI void tphase(const Params& P, LAS unsigned char* lds, int gw, int NGW, int wave, int lane_) {
    const int lane = opq(threadIdx.x) & 63;
    const bf16_t* BQ = (const bf16_t*)(P.ws + WS_BQKV); const float* GT = (const float*)(P.ws + WS_GATES);
    bf16_t* TB = (bf16_t*)(P.ws + WS_Y); bf16_t* AB = TB + (size_t)NITEM * 4096;
    LAS float* Ls = (LAS float*)(lds + wave * (64 * LSP * 4)); LAS float* gcs = (LAS float*)(lds + 8 * 64 * LSP * 4 + wave * 512); LAS float* bts = gcs + 64;
    LAS unsigned* ctr = (LAS unsigned*)(lds + 8 * 64 * LSP * 4 + 8 * 512);
    const int qi = lane & 31, hi = lane >> 5;
    const int G = NGW >> 3, ipw = (NITEM + G - 1) / G; const int it0 = (int)blockIdx.x * ipw; const int nit = (it0 + ipw <= NITEM) ? ipw : (NITEM > it0 ? NITEM - it0 : 0);
    if (threadIdx.x == 0) *ctr = 0u;
    __syncthreads();
    for (;;) {
        unsigned e = 0; if (lane == 0) e = atomicAdd((unsigned*)ctr, 1u);
        e = (unsigned)__builtin_amdgcn_readfirstlane((int)e);
        if ((int)e >= 2 * nit) break;
        const bool ahalf = (int)e >= nit; const int item = it0 + (ahalf ? (int)e - nit : (int)e);
        const int c = item % NCHUNK; int r_ = item / NCHUNK; const int dir = r_ & 1; r_ >>= 1; const int h = r_ & 3; const int b = r_ >> 2;
        const int mc = dir ? (c < 4 ? 3 - c : 71 - c) : c;
        const size_t row0 = (size_t)b * SEGR + 64 * mc;
#define ROWOF(i) (row0 + (dir ? 63 - (i) : (i)))
        const float beta = GT[ROWOF(lane) * 16 + 4 * dir + h]; float gc = GT[ROWOF(lane) * 16 + 8 + 4 * dir + h];
#pragma unroll
        for (int o = 1; o < 64; o <<= 1) { const float tt = __shfl_up(gc, o); if (lane >= o) gc += tt; }
        gcs[lane] = gc; bts[lane] = beta;
        bf16x8 kf[2][8];
#pragma unroll
        for (int I = 0; I < 2; ++I) { const bf16_t* rp = BQ + ROWOF(32 * I + qi) * 1536 + h * 128 + 8 * hi + 512;
#pragma unroll
            for (int dd = 0; dd < 8; ++dd) kf[I][dd] = *(const bf16x8*)(rp + 16 * dd); }
        LDS_WAIT();
        if (ahalf) {
            bf16_t* At = AB + (size_t)item * 4096;
            bf16x8 qf[2][8];
#pragma unroll
            for (int I = 0; I < 2; ++I) { const bf16_t* rp = BQ + ROWOF(32 * I + qi) * 1536 + h * 128 + 8 * hi;
#pragma unroll
                for (int dd = 0; dd < 8; ++dd) qf[I][dd] = *(const bf16x8*)(rp + 16 * dd); }
#pragma unroll
            for (int I = 0; I < 2; ++I) {
#pragma unroll
                for (int J = 0; J < 2; ++J) {
                    bf16_t* ap = At + (32 * I + 4 * hi) * 64 + 32 * J + qi;
                    if (J > I) {
#pragma unroll
                        for (int r = 0; r < 16; ++r) ap[((r & 3) + 8 * (r >> 2)) * 64] = 0;
                    } else {
                        f32x16 qk;
#pragma unroll
                        for (int r = 0; r < 16; ++r) qk[r] = 0.f;
#pragma unroll
                        for (int dd = 0; dd < 8; ++dd) qk = MFMA32(qf[I][dd], kf[J][dd], qk);
                        const int j = 32 * J + qi; const float gj = gcs[j];
#pragma unroll
                        for (int r = 0; r < 16; ++r) { const int i = 32 * I + crow(r, hi); const float dec = __expf(fminf(gcs[i] - gj, 0.f));
                            ap[((r & 3) + 8 * (r >> 2)) * 64] = (bf16_t)(pk2(i >= j ? qk[r] * dec : 0.f, 0.f) & 0xffffu); }
                    }
                    asm volatile("" ::: "memory");
                }
            }
        } else {
#pragma unroll
            for (int I = 0; I < 2; ++I)
#pragma unroll
                for (int J = 0; J <= I; ++J) {
                    f32x16 kk;
#pragma unroll
                    for (int r = 0; r < 16; ++r) kk[r] = 0.f;
#pragma unroll
                    for (int dd = 0; dd < 8; ++dd) kk = MFMA32(kf[I][dd], kf[J][dd], kk);
                    const int j = 32 * J + qi; const float gj = gcs[j];
#pragma unroll
                    for (int r = 0; r < 16; ++r) { const int i = 32 * I + crow(r, hi); const float dec = __expf(fminf(gcs[i] - gj, 0.f));
                        Ls[i * LSP + j] = i > j ? bts[i] * kk[r] * dec : 0.f; }
                    asm volatile("" ::: "memory");
                }
            LDS_WAIT();
            float tcol[64];
#pragma unroll
            for (int i = 0; i < 64; ++i) {
                float a = (lane == i) ? 1.f : 0.f, a1 = 0.f, a2 = 0.f, a3 = 0.f;
#pragma unroll
                for (int j4 = 0; j4 < i; j4 += 4) { const f32x4 Lr = *(const LAS f32x4*)(Ls + i * LSP + j4);
                    a -= Lr[0] * tcol[j4];
                    if (j4 + 1 < i) a1 -= Lr[1] * tcol[j4 + 1];
                    if (j4 + 2 < i) a2 -= Lr[2] * tcol[j4 + 2];
                    if (j4 + 3 < i) a3 -= Lr[3] * tcol[j4 + 3]; }
                tcol[i] = (a + a1) + (a2 + a3);
                asm volatile("" ::: "memory");
            }
            bf16_t* Tt = TB + (size_t)item * 4096;
#pragma unroll
            for (int i = 0; i < 64; ++i) Tt[i * 64 + lane] = (bf16_t)(pk2(tcol[i] * beta, 0.f) & 0xffffu);
        }
        LDS_WAIT();
#undef ROWOF
    }
    __syncthreads();
}

constexpr int SC_QS = 0, SC_KS = 17408, SC_VS = 34816, SC_TS = 52224, SC_AS = 61440, SC_EG = 70656, SC_EK = SC_EG + 256, SC_EL = SC_EG + 512, SC_BUF = 71680;
static_assert(2 * SC_BUF <= LDS_BYTES, "scan lds");
DI void scan_chain(const Params& P, LAS unsigned char* lds, int chain, int tid, int wave, int lane) {
    const int dir = chain & 1, h = (chain >> 1) & 3, b = chain >> 3;
    const bf16_t* BQ = (const bf16_t*)(P.ws + WS_BQKV); const float* GT = (const float*)(P.ws + WS_GATES);
    const bf16_t* TB = (const bf16_t*)(P.ws + WS_Y); const bf16_t* AB = TB + (size_t)NITEM * 4096;
    bf16_t* OB = (bf16_t*)P.out + (dir ? (size_t)MROWS * 512 : 0);
    const int ci = lane & 31, hi = lane >> 5, q4 = (lane & 15) >> 2, p4 = lane & 3, blk = (lane >> 4) & 1, cb = wave & 3;
    f32x16 S[4];
#pragma unroll
    for (int kb = 0; kb < 4; ++kb) {
#pragma unroll
        for (int r = 0; r < 16; ++r) S[kb][r] = 0.f; }
    if (wave >= 4) {
        u32x4 rq[4], rk[4], rv[4], rt[2], ra[2]; float graw = 0.f;
#define SC_LOAD(nn_) do { const int t2 = opq(tid) - 256; const int mc_ = dir ? ((nn_) < 4 ? 3 - (nn_) : 71 - (nn_)) : (nn_); const size_t row0_ = (size_t)b * SEGR + 64 * mc_; const size_t item_ = (size_t)chain * NCHUNK + (nn_); \
            _Pragma("unroll") for (int i = 0; i < 4; ++i) { const int cid = t2 + 256 * i, row = cid >> 4, cc = cid & 15, srow = dir ? 63 - row : row; const bf16_t* gp = BQ + (row0_ + srow) * 1536 + h * 128 + cc * 8; \
                rq[i] = *(const u32x4*)gp; rk[i] = *(const u32x4*)(gp + 512); rv[i] = *(const u32x4*)(gp + 1024); } \
            _Pragma("unroll") for (int i = 0; i < 2; ++i) { const int cid = t2 + 256 * i, row = cid >> 3, cc = cid & 7; rt[i] = *(const u32x4*)(TB + item_ * 4096 + row * 64 + cc * 8); ra[i] = *(const u32x4*)(AB + item_ * 4096 + row * 64 + cc * 8); } \
            if (wave == 4) { const int ln = t2 & 63; graw = GT[(row0_ + (dir ? 63 - ln : ln)) * 16 + 8 + 4 * dir + h]; } } while (0)
        SC_LOAD(0);
        for (int nn = 0; nn < NCHUNK; ++nn) {
            LAS unsigned char* B = lds + (nn & 1) * SC_BUF;
            const int t2 = opq(tid) - 256;
            if (wave == 4) { const int ln = t2 & 63; float gc = graw;
#pragma unroll
                for (int o = 1; o < 64; o <<= 1) { const float tt = __shfl_up(gc, o); if (ln >= o) gc += tt; }
                const float gl = __shfl(gc, 63);
                ((LAS float*)(B + SC_EG))[ln] = __expf(gc); ((LAS float*)(B + SC_EK))[ln] = __expf(gl - gc); if (ln == 63) ((LAS float*)(B + SC_EL))[0] = __expf(gc); }
#pragma unroll
            for (int i = 0; i < 4; ++i) { const int cid = t2 + 256 * i, row = cid >> 4, cc = cid & 15; *(LAS u32x4*)(B + SC_QS + row * 272 + cc * 16) = rq[i]; *(LAS u32x4*)(B + SC_KS + row * 272 + cc * 16) = rk[i]; *(LAS u32x4*)(B + SC_VS + row * 272 + cc * 16) = rv[i]; }
#pragma unroll
            for (int i = 0; i < 2; ++i) { const int cid = t2 + 256 * i, row = cid >> 3, cc = cid & 7; *(LAS u32x4*)(B + SC_TS + row * 144 + cc * 16) = rt[i]; *(LAS u32x4*)(B + SC_AS + row * 144 + cc * 16) = ra[i]; }
            if (nn + 1 < NCHUNK) SC_LOAD(nn + 1);
            __syncthreads();
        }
#undef SC_LOAD
        __syncthreads();
        return;
    }
    __syncthreads();
    for (int n = 0; n < NCHUNK; ++n) {
        {
            const LAS unsigned char* B = lds + (n & 1) * SC_BUF;
            const LAS unsigned char *QS = B + SC_QS, *KS = B + SC_KS, *VS = B + SC_VS, *TS = B + SC_TS, *AS = B + SC_AS; const LAS float *EG = (const LAS float*)(B + SC_EG), *EK = (const LAS float*)(B + SC_EK);
            const int mc = dir ? (n < 4 ? 3 - n : 71 - n) : n; const size_t row0 = (size_t)b * SEGR + 64 * mc;
            bf16x8 rfr[2][2], vnfr[2][2], vsfr[2][2], Sfr[4][2];
#pragma unroll
            for (int kb = 0; kb < 4; ++kb) { Sfr[kb][0] = pack8(S[kb], 0); Sfr[kb][1] = pack8(S[kb], 1); }
#pragma unroll
            for (int rb = 0; rb < 2; ++rb) { f32x16 acc;
#pragma unroll
                for (int r = 0; r < 16; ++r) acc[r] = 0.f;
#pragma unroll
                for (int kb = 0; kb < 4; ++kb)
#pragma unroll
                    for (int s = 0; s < 2; ++s) acc = MFMA32(ld2x8(KS + (32 * rb + ci) * 272 + (32 * kb + 16 * s + 4 * hi) * 2), Sfr[kb][s], acc);
                f32x16 rr;
#pragma unroll
                for (int g = 0; g < 4; ++g) { const s16x4 vv = trrd(VS + (32 * rb + 8 * g + 4 * hi + q4) * 272 + (32 * cb + 16 * blk) * 2 + 8 * p4); const f32x4 eg = *(const LAS f32x4*)(EG + 32 * rb + 8 * g + 4 * hi);
#pragma unroll
                    for (int j = 0; j < 4; ++j) rr[4 * g + j] = bf2f(vv[j]) - eg[j] * acc[4 * g + j]; }
                rfr[rb][0] = pack8(rr, 0); rfr[rb][1] = pack8(rr, 1); }
            asm volatile("" ::: "memory");
#pragma unroll
            for (int ob = 0; ob < 2; ++ob) { f32x16 acc;
#pragma unroll
                for (int r = 0; r < 16; ++r) acc[r] = 0.f;
#pragma unroll
                for (int rb = 0; rb <= ob; ++rb)
#pragma unroll
                    for (int s = 0; s < 2; ++s) acc = MFMA32(ld2x8(TS + (32 * ob + ci) * 144 + (32 * rb + 16 * s + 4 * hi) * 2), rfr[rb][s], acc);
                vnfr[ob][0] = pack8(acc, 0); vnfr[ob][1] = pack8(acc, 1);
#pragma unroll
                for (int g = 0; g < 4; ++g) { const f32x4 ek = *(const LAS f32x4*)(EK + 32 * ob + 8 * g + 4 * hi);
#pragma unroll
                    for (int j = 0; j < 4; ++j) acc[4 * g + j] *= ek[j]; }
                vsfr[ob][0] = pack8(acc, 0); vsfr[ob][1] = pack8(acc, 1); }
            asm volatile("" ::: "memory");
#pragma unroll
            for (int ob = 0; ob < 2; ++ob) { f32x16 acc;
#pragma unroll
                for (int r = 0; r < 16; ++r) acc[r] = 0.f;
#pragma unroll
                for (int kb = 0; kb < 4; ++kb)
#pragma unroll
                    for (int s = 0; s < 2; ++s) acc = MFMA32(ld2x8(QS + (32 * ob + ci) * 272 + (32 * kb + 16 * s + 4 * hi) * 2), Sfr[kb][s], acc);
#pragma unroll
                for (int g = 0; g < 4; ++g) { const f32x4 eg = *(const LAS f32x4*)(EG + 32 * ob + 8 * g + 4 * hi);
#pragma unroll
                    for (int j = 0; j < 4; ++j) acc[4 * g + j] *= eg[j]; }
#pragma unroll
                for (int rb = 0; rb <= ob; ++rb)
#pragma unroll
                    for (int s = 0; s < 2; ++s) acc = MFMA32(ld2x8(AS + (32 * ob + ci) * 144 + (32 * rb + 16 * s + 4 * hi) * 2), vnfr[rb][s], acc);
#pragma unroll
                for (int r = 0; r < 16; ++r) { const int i = 32 * ob + crow(r, hi); OB[(row0 + (dir ? 63 - i : i)) * 512 + h * 128 + 32 * cb + ci] = (bf16_t)(pk2(acc[r], 0.f) & 0xffffu); } }
            asm volatile("" ::: "memory");
            const float el = ((const LAS float*)(B + SC_EL))[0];
#pragma unroll
            for (int kb = 0; kb < 4; ++kb) {
#pragma unroll
                for (int r = 0; r < 16; ++r) S[kb][r] *= el;
#pragma unroll
                for (int rb = 0; rb < 2; ++rb)
#pragma unroll
                    for (int s = 0; s < 2; ++s) { const LAS unsigned char* kp = KS + (32 * rb + 16 * s + 4 * hi + q4) * 272 + (32 * kb + 16 * blk) * 2 + 8 * p4;
                        S[kb] = MFMA32(cat8(trrd(kp), trrd(kp + 8 * 272)), vsfr[rb][s], S[kb]); }
                asm volatile("" ::: "memory"); }
        }
        __syncthreads();
    }
}
DI void scan_attn_phase(const Params& P, LAS unsigned char* lds, int i2, int tid_, int wave, int lane_) {
    const int tid = opq(threadIdx.x), lane = tid & 63;
    const int G = gridDim.x;
    if ((int)blockIdx.x < 64) { scan_chain(P, lds, blockIdx.x, tid, wave, lane); return; }
    bf16_t* QKV = (bf16_t*)(P.ws + WS_QKV);
    for (int u = blockIdx.x - 64; u < 1088; u += G - 64) {
        const int qb = u % 17, h = (u / 17) & 7, b = u / 136;
        bf16_t* base = QKV + (size_t)b * SEGR * ABP; bf16_t* q = base + (size_t)(256 * qb) * ABP + h * 64;
        const bf16_t* K = base + 1024 + (h >> 2) * 64; const bf16_t* V = base + 1152 + (h >> 2) * 64;
        const float sk = P.in[I_SINK][i2 * 8 + h] * LOG2E;
        if (qb == 0) attn_unit<64>(lds, q, q, ABP, K, V, ABP, 4, 0, 0, false, 0, true, sk, -1, tid, wave, lane);
        else { const int pq0 = 256 * qb; const int lo = pq0 - 128 < CTXL ? CTXL : pq0 - 128; const int hi_ = pq0 + 384 > SEGR ? SEGR : pq0 + 384;
            attn_unit<64>(lds, q, q, ABP, K, V, ABP, 4, lo, (hi_ - lo) >> 6, true, pq0, true, sk, pq0 - CTXL, tid, wave, lane); }
    }
    __syncthreads();
    convert_layer(P, 2 * i2 + 1, lds, ((int)blockIdx.x - 64) * 8 + wave, (G - 64) * 8, wave, lane, 1);
}
DI void combine_pass(const Params& P, int i2, int gw, int NGW, int lane_) {
    const int lane = opq(threadIdx.x) & 63;
    bf16_t* QKV = (bf16_t*)(P.ws + WS_QKV); const bf16_t* OF = (const bf16_t*)P.out; const bf16_t* OBk = OF + (size_t)MROWS * 512;
    const f32x4 gn0 = *(const f32x4*)(P.in[I_GNORM] + i2 * 128 + (lane & 15) * 8), gn1 = *(const f32x4*)(P.in[I_GNORM] + i2 * 128 + (lane & 15) * 8 + 4);
    const int RPW = (MROWS + NGW - 1) / NGW; const int r0 = gw * RPW, r1 = (r0 + RPW) < MROWS ? (r0 + RPW) : MROWS;
    u32x4 na, nc, nz;
#define CB_LOAD(r) do { na = *(const u32x4*)(OF + (size_t)(r) * 512 + lane * 8); nc = *(const u32x4*)(OBk + (size_t)(r) * 512 + lane * 8); nz = *(const u32x4*)(QKV + (size_t)(r) * ABP + 512 + lane * 8); } while (0)
    if (r0 < r1) CB_LOAD(r0);
    for (int row = r0; row < r1; ++row) {
        const u32x4 a = na, c = nc, zw = nz;
        if (row + 1 < r1) CB_LOAD(row + 1);
        bf16_t* zp = QKV + (size_t)row * ABP + 512 + lane * 8;
        float x[8] = {bflo(a.x) + bflo(c.x), bfhi(a.x) + bfhi(c.x), bflo(a.y) + bflo(c.y), bfhi(a.y) + bfhi(c.y), bflo(a.z) + bflo(c.z), bfhi(a.z) + bfhi(c.z), bflo(a.w) + bflo(c.w), bfhi(a.w) + bfhi(c.w)};
        const float z[8] = {bflo(zw.x), bfhi(zw.x), bflo(zw.y), bfhi(zw.y), bflo(zw.z), bfhi(zw.z), bflo(zw.w), bfhi(zw.w)};
        float ss = 0.f;
#pragma unroll
        for (int e = 0; e < 8; ++e) ss += x[e] * x[e];
        ss += __shfl_xor(ss, 1); ss += __shfl_xor(ss, 2); ss += __shfl_xor(ss, 4); ss += __shfl_xor(ss, 8);
        const float rinv = 1.f / sqrtf(ss * (1.f / 128.f) + LN_EPS);
#pragma unroll
        for (int e = 0; e < 4; ++e) { x[e] = x[e] * rinv * gn0[e] * siluf(z[e]); x[e + 4] = x[e + 4] * rinv * gn1[e] * siluf(z[e + 4]); }
        u32x4 o; o.x = pk2(x[0], x[1]); o.y = pk2(x[2], x[3]); o.z = pk2(x[4], x[5]); o.w = pk2(x[6], x[7]); *(u32x4*)zp = o;
    }
#undef CB_LOAD
}


#define XB_TMO      128
#define XB_XCNT(j)  (256  + 64 * (j))
#define XB_XSUB(j)  (1280 + 64 * (j))
#define XB_XGEN(j)  (2304 + 64 * (j))
#define XB_TOP      3328
#define XB_TOPGEN   3392
#define XCD_BAR_WORDS 3456
#define XB_SPIN_CAP (1u << 18)
DI unsigned xb_ld(unsigned* p)              { return __hip_atomic_load(p, __ATOMIC_RELAXED, __HIP_MEMORY_SCOPE_AGENT); }
DI unsigned xb_add(unsigned* p, unsigned v) { return __hip_atomic_fetch_add(p, v, __ATOMIC_RELAXED, __HIP_MEMORY_SCOPE_AGENT); }
DI unsigned xb_xcc_id() { return (unsigned)__builtin_amdgcn_s_getreg((3 << 11) | 20) & 0xFu; }
#define XB_SPIN(cond, bar) do { unsigned _sp = 0; while (cond) { __builtin_amdgcn_s_sleep(1); \
    if ((++_sp & 255u) == 0u) { if (xb_ld(&(bar)[XB_TMO])) break; if (_sp > XB_SPIN_CAP) { atomicAdd(&(bar)[XB_TMO], 1u); break; } } } } while (0)
struct XcdBarrier { unsigned* bar; unsigned x; volatile LAS unsigned* st; };
DI XcdBarrier xcd_barrier_post(unsigned* bar, volatile LAS unsigned* st) {
    XcdBarrier b; b.bar = bar; b.x = (unsigned)__builtin_amdgcn_readfirstlane((int)xb_xcc_id()); b.st = st;
    if (threadIdx.x == 0) (void)xb_add(&bar[XB_XCNT(b.x)], 1u);
    return b;
}
DI void xcd_barrier_complete(unsigned* bar, unsigned x, unsigned& nloc, unsigned& nx) {
    const unsigned G = gridDim.x * gridDim.y * gridDim.z;
    unsigned sum, cnt, mine, sp = 0u;
    for (;;) {
        sum = 0u; cnt = 0u; mine = 0u;
#pragma unroll
        for (unsigned j = 0; j < 16; ++j) { const unsigned c = xb_ld(&bar[XB_XCNT(j)]); sum += c; cnt += (c > 0u) ? 1u : 0u; mine = (j == x) ? c : mine; }
        if (sum == G) break;
        __builtin_amdgcn_s_sleep(1);
        if ((++sp & 255u) == 0u) { if (xb_ld(&bar[XB_TMO])) break; if (sp > XB_SPIN_CAP) { atomicAdd(&bar[XB_TMO], 1u); break; } }
    }
    nloc = mine > 0u ? mine : 1u; nx = cnt > 0u ? cnt : 1u;
}
DI void xcd_barrier(const XcdBarrier& b) {
    asm volatile("s_waitcnt vmcnt(0)" ::: "memory");
    __syncthreads();
    if (threadIdx.x == 0) {
        unsigned* bar = b.bar; const unsigned bx = (unsigned)__builtin_amdgcn_readfirstlane((int)b.x);
        __builtin_amdgcn_s_waitcnt(0);
        unsigned nloc = b.st[0], nx = b.st[1];
        if (nloc == 0u) { xcd_barrier_complete(bar, bx, nloc, nx); b.st[0] = nloc; b.st[1] = nx; }
        const unsigned old = xb_add(&bar[XB_XSUB(bx)], 1u);
        const unsigned gen = old / nloc;
        if (old + 1u == (gen + 1u) * nloc) {
            __builtin_amdgcn_fence(__ATOMIC_RELEASE, "agent");
            asm volatile("s_waitcnt vmcnt(0)" ::: "memory");
            const unsigned og = xb_add(&bar[XB_TOP], 1u);
            const unsigned tg = og / nx;
            if (og + 1u == (tg + 1u) * nx) xb_add(&bar[XB_TOPGEN], 1u);
            else XB_SPIN(xb_ld(&bar[XB_TOPGEN]) == tg, bar);
            __builtin_amdgcn_fence(__ATOMIC_ACQUIRE, "agent");
            xb_add(&bar[XB_XGEN(bx)], 1u);
            asm volatile("s_waitcnt vmcnt(0)" ::: "memory");
        } else {
            XB_SPIN(xb_ld(&bar[XB_XGEN(bx)]) == gen, bar);
            __builtin_amdgcn_fence(__ATOMIC_ACQUIRE, "agent");
            asm volatile("s_waitcnt vmcnt(0)" ::: "memory");
        }
    }
    __syncthreads();
}

#define GSYNC(id) xcd_barrier(bar)
__global__ void __launch_bounds__(512, 2) mega(Params P) {
    extern __shared__ __attribute__((aligned(16))) unsigned char lds[];
    cg::grid_group grid = cg::this_grid();
    LAS unsigned char* l3 = (LAS unsigned char*)lds;
    const int wave = __builtin_amdgcn_readfirstlane(threadIdx.x >> 6);
    const int G = gridDim.x, gw = blockIdx.x * 8 + wave, NGW = G * 8; const int tid = 0, lane = 0;
    unsigned char* ws = P.ws;
    bf16_t* H = (bf16_t*)P.out; bf16_t* ACT = (bf16_t*)(ws + WS_QKV); bf16_t* QKV = ACT; bf16_t* Y = (bf16_t*)(ws + WS_Y); bf16_t* YP = (bf16_t*)(ws + WS_YP);

    { LAS unsigned* misc = (LAS unsigned*)(l3 + LDS_BYTES - 64); if (threadIdx.x < 16) misc[threadIdx.x] = 0u; }
    __syncthreads();
    const XcdBarrier bar = xcd_barrier_post((unsigned*)P.ws, (volatile LAS unsigned*)(l3 + LDS_BYTES - 64));
    mod_phase(P, lds, tid, wave, lane);
    __syncthreads();
    convert_layer(P, 0, l3, gw, NGW, wave, lane);
    grid.sync();
    GSYNC(10);
    init_pass(P, gw, NGW, lane);
    GSYNC(10);
    for (int l = 0; l < 4; ++l) {
        for (int half = 0; half < 2; ++half) {
            { const int sk = (l == 3 && half == 1) ? 1 : 0; pg8::Gemm g{H, DM, (const bf16_t*)(ws + (half ? W_GU1 : W_GU0)), sk ? pg8::TAIL_ROW0 : MROWS, 2 * DFF, DM, sk}; pg8::EpiSwiglu E{ACT}; pg8::gemm_phase<pg8::StaticOrder>(l3, g, G, (int)blockIdx.x, E); }
            GSYNC(1);
            { const int sk = (l == 3 && half == 1) ? 1 : 0; pg8::Gemm g{ACT, DFF, (const bf16_t*)(ws + (half ? W_DN1 : W_DN0)), sk ? pg8::TAIL_ROW0 : MROWS, DM, DFF, sk}; pg8::EpiBf16 E{Y, DM, YP}; pg8::gemm_phase<pg8::TailSplitOrder>(l3, g, G, (int)blockIdx.x, E); }
            GSYNC(2);
            ln_pass(P, l, half * 2, 0.5f, (l == 3 && half == 1) ? 0 : 7, gw, NGW, lane);
            if (half == 1 && l < 3) { __syncthreads(); convert_layer(P, l + 1, l3, gw, NGW, wave, lane, (l & 1) ? 0 : 2); }
            GSYNC(3);
            if (half == 0) {
                if (l & 1) {
                    { pg8::Gemm g{H, DM, (const bf16_t*)(ws + W_IN), MROWS, CINW, DM, 0}; pg8::EpiBf16 E{QKV, CINW, nullptr}; pg8::gemm_phase<pg8::StaticOrder>(l3, g, G, (int)blockIdx.x, E); }
                    GSYNC(4);
                    cprep_pass(P, l >> 1, gw, NGW, lane);
                    GSYNC(5);
                    attn_c_phase(P, (char*)lds, l < 3, l >> 1, tid, wave, lane);
                    GSYNC(6);
                    { const int sk = (l == 3) ? 1 : 0; pg8::Gemm g{QKV, CINW, (const bf16_t*)(ws + W_OUT), sk ? pg8::TAIL_ROW0 : MROWS, DM, DM, sk}; pg8::EpiBf16 E{Y, DM, YP}; pg8::gemm_phase<pg8::TailSplitOrder>(l3, g, G, (int)blockIdx.x, E); }
                    GSYNC(4);
                    ln_pass(P, l, 1, 1.f, (l == 3) ? 0 : 3, gw, NGW, lane);
                } else {
                    { pg8::Gemm g{H, DM, (const bf16_t*)(ws + W_IN), MROWS, ABP, DM, 0}; pg8::EpiBf16 E{QKV, ABP, nullptr}; pg8::gemm_phase<pg8::StaticOrder>(l3, g, G, (int)blockIdx.x, E); }
                    GSYNC(4);
                    abprep_pass(P, l >> 1, l3, gw, NGW, lane);
                    GSYNC(7);
#ifndef NO_TPHASE
                    tphase(P, l3, gw, NGW, wave, lane);
#endif
                    GSYNC(8);
#ifndef NO_SCAN
                    scan_attn_phase(P, l3, l >> 1, tid, wave, lane);
#endif
                    GSYNC(9);
                    combine_pass(P, l >> 1, gw, NGW, lane);
                    GSYNC(11);
                    { pg8::Gemm g{QKV, ABP, (const bf16_t*)(ws + W_OUT), MROWS, DM, DM, 0}; pg8::EpiBf16 E{Y, DM, YP}; pg8::gemm_phase<pg8::TailSplitOrder>(l3, g, G, (int)blockIdx.x, E); }
                    GSYNC(4);
                    ln_pass(P, l, 1, 1.f, 3, gw, NGW, lane);
                }
                GSYNC(3);
            }
        }
    }
}

extern "C" void kernel_launch(void* const* d_in, const int* in_sizes, int n_in, void* d_out, int out_size, void* d_ws, size_t ws_size, hipStream_t stream) {
    static int grid = 0;
    if (grid == 0) {
        int dev = 0, cus = 0, per_cu = 0;
        hipGetDevice(&dev); hipDeviceGetAttribute(&cus, hipDeviceAttributeMultiprocessorCount, dev);
        hipFuncSetAttribute((const void*)mega, hipFuncAttributeMaxDynamicSharedMemorySize, LDS_BYTES);
        hipOccupancyMaxActiveBlocksPerMultiprocessor(&per_cu, (const void*)mega, 512, LDS_BYTES);
        if (per_cu < 1) per_cu = 1;
        grid = cus * 1;
        if (ws_size < WS_END) fprintf(stderr, "kernel_launch: workspace too small: %zu < %zu\n", ws_size, (size_t)WS_END);
        (void)hipGetLastError();
    }
    (void)hipMemsetAsync(d_ws, 0, 16384, stream);
    Params p{};
    for (int i = 0; i < 21; ++i) p.in[i] = (const float*)d_in[i];
    p.out = (float*)d_out; p.ws = (unsigned char*)d_ws;
    void* args[] = {&p};
    hipError_t e = hipLaunchCooperativeKernel((const void*)mega, dim3(grid), dim3(512), args, LDS_BYTES, stream);
    if (e != hipSuccess) fprintf(stderr, "cooperative launch failed: %s (grid %d)\n", hipGetErrorString(e), grid);
}
```
